# Optimizing an MI355X kernel written in HIP

```python
import math
import jax
import jax.numpy as jnp
from jax import lax
import numpy as np

D_MODEL = 1024
BATCH = 4
SEQ = 4096
DEPTH = 4

N_HEADS = 16
HEAD_DIM = D_MODEL // N_HEADS
D_FF = 4 * D_MODEL
N_MIXERS = 4
N_REPEATS = DEPTH // N_MIXERS
RMS_EPS = 1e-6
NEG_INF = -1e30
POS_BIG = 1e30
TINY = 1e-30

REL_BUCKETS = 32
REL_MAX_EXACT = REL_BUCKETS // 2
REL_MAX_DIST = 2048

BAND_BLOCK = 128
Q_BLOCK = 128
GATHER_CHUNK = 32

DILATED_PATTERNS = ((128, 1), (512, 4), (2048, 16))

NSA_KV_HEADS = 4
NSA_GROUP = N_HEADS // NSA_KV_HEADS
NSA_KV_DIM = NSA_KV_HEADS * HEAD_DIM
CMP_STRIDE = 16
CMP_BLOCK = 2 * CMP_STRIDE
CMP_HIDDEN = 256
SEL_BLOCK = 64
SEL_TOPK = 16
NSA_WINDOW = 512
NSA_IN_DIM = D_MODEL + 6 * NSA_KV_DIM + 3 * N_HEADS

FOX_IN_DIM = 3 * D_MODEL + N_HEADS

MOBA_BLOCK = 256
MOBA_TOPK = 3

kernel_name = "hybrid_dilated_nsa_fox_moba"


def rmsnorm(x, g):
    x32 = x.astype(jnp.float32)
    y = x32 * lax.rsqrt(jnp.mean(x32 * x32, axis=-1, keepdims=True) + RMS_EPS)
    return y.astype(x.dtype) * g


def rel_bucket(dist):
    d = jnp.maximum(dist, 0)
    df = jnp.maximum(d.astype(jnp.float32), 1.0)
    large = REL_MAX_EXACT + (jnp.log(df / REL_MAX_EXACT) / math.log(REL_MAX_DIST / REL_MAX_EXACT)
                             * (REL_BUCKETS - REL_MAX_EXACT)).astype(jnp.int32)
    large = jnp.minimum(large, REL_BUCKETS - 1)
    return jnp.where(d < REL_MAX_EXACT, d, large)


def masked_stats(logits, mask):
    l = jnp.where(mask, logits, NEG_INF)
    m = jnp.max(l, axis=-1, keepdims=True)
    p = jnp.where(mask, jnp.exp(l - m), 0.0)
    s = jnp.sum(p, axis=-1, keepdims=True)
    return p, m, s


def combine_by_denominators(parts):
    m_all = parts[0][1]
    for _, m, _ in parts[1:]:
        m_all = jnp.maximum(m_all, m)
    w = [s * jnp.exp(m - m_all) for _, m, s in parts]
    num = sum(wi * o for wi, (o, _, _) in zip(w, parts))
    return num / jnp.maximum(sum(w), TINY)


def split_chunks(t, axis, size):
    shp = t.shape
    t = t.reshape(shp[:axis] + (shp[axis] // size, size) + shp[axis + 1:])
    return jnp.moveaxis(t, axis, 0)


def merge_chunks(t, axis):
    t = jnp.moveaxis(t, 0, axis)
    shp = t.shape
    return t.reshape(shp[:axis] + (shp[axis] * shp[axis + 1],) + shp[axis + 2:])


def banded_attention(q, k, v, bias_tab, max_dist, dilation):
    b, kh, g, L, dh = q.shape
    blk = BAND_BLOCK
    n_prev = -(-max_dist // blk)
    nb = -(-L // blk)
    pad = nb * blk - L
    qb = jnp.pad(q, ((0, 0), (0, 0), (0, 0), (0, pad), (0, 0))).reshape(b, kh, g, nb, blk, dh)

    def windows(t):
        tp = jnp.pad(t, ((0, 0), (0, 0), (n_prev * blk, pad), (0, 0))).reshape(b, kh, n_prev + nb, blk, dh)
        return jnp.concatenate([tp[:, :, i:i + nb] for i in range(n_prev + 1)], axis=3)

    kw, vw = windows(k), windows(v)
    nk = (n_prev + 1) * blk
    qi = jnp.arange(blk)[:, None]
    kj = jnp.arange(nk)[None, :]
    rel = qi + n_prev * blk - kj
    kpos = (jnp.arange(nb) * blk)[:, None, None] - n_prev * blk + kj[None]
    mask = (rel >= 0) & (rel <= max_dist) & (kpos >= 0)
    bias = jnp.transpose(bias_tab[rel_bucket(rel * dilation)], (2, 3, 0, 1))[None, :, :, None]
    logits = jnp.einsum("bhgnqd,bhnkd->bhgnqk", qb, kw, preferred_element_type=jnp.float32) * (dh ** -0.5) + bias
    p, m, s = masked_stats(logits, mask)
    o = jnp.einsum("bhgnqk,bhnkd->bhgnqd", p.astype(v.dtype), vw,
                   preferred_element_type=jnp.float32) / jnp.maximum(s, TINY)

    def unblock(t):
        return t.reshape(b, kh, g, nb * blk, t.shape[-1])[:, :, :, :L]

    return unblock(o), unblock(m), unblock(s)


def dilated_mixer(h, w_in, q_gain, k_gain, rel_table):
    b, S, _ = h.shape
    qkv = (h @ w_in).reshape(b, S, 3, N_HEADS, HEAD_DIM)
    q = rmsnorm(qkv[:, :, 0], q_gain)
    k = rmsnorm(qkv[:, :, 1], k_gain)
    v = qkv[:, :, 2]
    parts = []
    for window, dil in DILATED_PATTERNS:
        n = S // dil

        def by_residue(t):
            return t.reshape(b, n, dil, N_HEADS, HEAD_DIM).transpose(0, 2, 3, 1, 4).reshape(b * dil, N_HEADS, n, HEAD_DIM)

        def back(t):
            c = t.shape[-1]
            return t.reshape(b, dil, N_HEADS, n, c).transpose(0, 3, 1, 2, 4).reshape(b, S, N_HEADS, c)

        o, m, s = banded_attention(by_residue(q)[:, :, None], by_residue(k), by_residue(v),
                                   rel_table[:, :, None], window // dil, dil)
        parts.append((back(o), back(m), back(s)))
    return combine_by_denominators(parts).reshape(b, S, D_MODEL)


def nsa_mixer(h, w_in, cmp_pos, cmp_w1, cmp_w2, q_gain, k_gain, rel_table):
    b, S, _ = h.shape
    KH, G, dh = NSA_KV_HEADS, NSA_GROUP, HEAD_DIM
    scale = dh ** -0.5
    proj = h @ w_in
    splits = np.cumsum([D_MODEL] + [NSA_KV_DIM] * 6).tolist()
    q, k_c, v_c, k_s, v_s, k_w, v_w, gate_logits = jnp.split(proj, splits, axis=-1)
    q = rmsnorm(q.reshape(b, S, KH, G, dh), q_gain).transpose(0, 2, 3, 1, 4)

    def heads(t):
        return t.reshape(b, S, KH, dh).transpose(0, 2, 1, 3)

    k_c, v_c, k_s, v_s, k_w, v_w = map(heads, (k_c, v_c, k_s, v_s, k_w, v_w))
    k_s, k_w = rmsnorm(k_s, k_gain), rmsnorm(k_w, k_gain)
    gates = jax.nn.sigmoid(gate_logits.astype(jnp.float32)).reshape(b, S, KH, G, 3).transpose(0, 2, 3, 1, 4)
    bias_tab = rel_table.reshape(REL_BUCKETS, KH, G)
    qpos = jnp.arange(S)

    n_c = S // CMP_STRIDE - 1

    def compress(t, pos, w1, w2):
        chunks = t.reshape(b, KH, S // CMP_STRIDE, CMP_STRIDE, dh)
        blocks = jnp.concatenate([chunks[:, :, :-1], chunks[:, :, 1:]], axis=3) + pos
        hid = jax.nn.gelu(blocks.reshape(b, KH, n_c, CMP_BLOCK * dh) @ w1)
        return hid @ w2

    k_cmp = rmsnorm(compress(k_c, cmp_pos[0], cmp_w1[0], cmp_w2[0]), k_gain)
    v_cmp = compress(v_c, cmp_pos[1], cmp_w1[1], cmp_w2[1])
    c_start = jnp.arange(n_c) * CMP_STRIDE
    dist_c = qpos[:, None] - (c_start + CMP_BLOCK - 1)[None, :]
    bias_c = jnp.transpose(bias_tab[rel_bucket(dist_c)], (2, 3, 0, 1))
    logits_c = jnp.einsum("bhgsd,bhnd->bhgsn", q, k_cmp, preferred_element_type=jnp.float32) * scale + bias_c
    p_c, _, s_c = masked_stats(logits_c, dist_c >= 0)
    probs_c = p_c / jnp.maximum(s_c, TINY)
    o_cmp = jnp.einsum("bhgsn,bhnd->bhgsd", probs_c.astype(v_cmp.dtype), v_cmp, preferred_element_type=jnp.float32)

    n_sel = S // SEL_BLOCK
    s_start = jnp.arange(n_sel) * SEL_BLOCK
    overlap = ((c_start[:, None] < s_start[None, :] + SEL_BLOCK)
               & (c_start[:, None] + CMP_BLOCK > s_start[None, :])).astype(jnp.float32)
    imp = jnp.einsum("bhgsn,nj->bhsj", probs_c, overlap)
    own = (qpos // SEL_BLOCK)[:, None]
    jj = jnp.arange(n_sel)[None, :]
    imp = jnp.where(jj == own, POS_BIG, jnp.where(jj < own, imp, NEG_INF))
    k_top = min(SEL_TOPK, n_sel)
    top_val, top_idx = lax.top_k(imp, k_top)
    top_valid = top_val > 0.5 * NEG_INF
    kb = k_s.reshape(b, KH, n_sel, SEL_BLOCK, dh)
    vb = v_s.reshape(b, KH, n_sel, SEL_BLOCK, dh)
    b_i = jnp.arange(b)[:, None, None, None]
    h_i = jnp.arange(KH)[None, :, None, None]
    g_i = jnp.arange(G)[None, None, :, None, None]
    tab = jnp.transpose(bias_tab, (1, 2, 0))
    C = GATHER_CHUNK

    def sel_chunk(args):
        qc, idx, valid, pos = args
        kg = kb[b_i, h_i, idx].reshape(b, KH, C, k_top * SEL_BLOCK, dh)
        vg = vb[b_i, h_i, idx].reshape(b, KH, C, k_top * SEL_BLOCK, dh)
        kpos = (idx[..., None] * SEL_BLOCK + jnp.arange(SEL_BLOCK)).reshape(b, KH, C, k_top * SEL_BLOCK)
        dist = pos[:, None] - kpos
        mask = (jnp.repeat(valid, SEL_BLOCK, axis=-1) & (dist >= 0))[:, :, None]
        bias = tab[h_i[:, :, None], g_i, rel_bucket(dist)[:, :, None]]
        logits = jnp.einsum("bhgqd,bhqkd->bhgqk", qc, kg, preferred_element_type=jnp.float32) * scale + bias
        p, _, s = masked_stats(logits, mask)
        return jnp.einsum("bhgqk,bhqkd->bhgqd", p.astype(vg.dtype), vg,
                          preferred_element_type=jnp.float32) / jnp.maximum(s, TINY)

    o_sel = merge_chunks(lax.map(sel_chunk, (split_chunks(q, 3, C), split_chunks(top_idx, 2, C),
                                             split_chunks(top_valid, 2, C), split_chunks(qpos, 0, C))), 3)

    o_win, _, _ = banded_attention(q, k_w, v_w, bias_tab, NSA_WINDOW - 1, 1)

    o = gates[..., 0:1] * o_cmp + gates[..., 1:2] * o_sel + gates[..., 2:3] * o_win
    return o.transpose(0, 3, 1, 2, 4).reshape(b, S, D_MODEL)


def fox_mixer(h, w_in, b_f, q_gain, k_gain):
    b, S, _ = h.shape
    scale = HEAD_DIM ** -0.5
    proj = h @ w_in
    qkv = proj[..., :3 * D_MODEL].reshape(b, S, 3, N_HEADS, HEAD_DIM)
    q = rmsnorm(qkv[:, :, 0], q_gain).transpose(0, 2, 1, 3)
    k = rmsnorm(qkv[:, :, 1], k_gain).transpose(0, 2, 1, 3)
    v = qkv[:, :, 2].transpose(0, 2, 1, 3)
    log_f = jax.nn.log_sigmoid((proj[..., 3 * D_MODEL:] + b_f).astype(jnp.float32))
    c = jnp.cumsum(log_f, axis=1).transpose(0, 2, 1)
    kpos = jnp.arange(S)

    def q_block(args):
        qb, cb, pos = args
        logits = (jnp.einsum("bhqd,bhkd->bhqk", qb, k, preferred_element_type=jnp.float32) * scale
                  + (cb[..., :, None] - c[:, :, None, :]))
        p, _, s = masked_stats(logits, pos[:, None] >= kpos[None, :])
        return jnp.einsum("bhqk,bhkd->bhqd", p.astype(v.dtype), v,
                          preferred_element_type=jnp.float32) / jnp.maximum(s, TINY)

    o = merge_chunks(lax.map(q_block, (split_chunks(q, 2, Q_BLOCK), split_chunks(c, 2, Q_BLOCK),
                                       split_chunks(kpos, 0, Q_BLOCK))), 2)
    return o.transpose(0, 2, 1, 3).reshape(b, S, D_MODEL)


def moba_mixer(h, w_in, q_gain, k_gain, rel_table):
    b, S, _ = h.shape
    H, dh = N_HEADS, HEAD_DIM
    scale = dh ** -0.5
    qkv = (h @ w_in).reshape(b, S, 3, H, dh)
    q = rmsnorm(qkv[:, :, 0], q_gain).transpose(0, 2, 1, 3)
    k = rmsnorm(qkv[:, :, 1], k_gain).transpose(0, 2, 1, 3)
    v = qkv[:, :, 2].transpose(0, 2, 1, 3)
    nblk = -(-S // MOBA_BLOCK)
    pad = nblk * MOBA_BLOCK - S

    def to_blocks(t):
        return jnp.pad(t, ((0, 0), (0, 0), (0, pad), (0, 0))).reshape(b, H, nblk, MOBA_BLOCK, dh)

    qb, kb, vb = to_blocks(q), to_blocks(k), to_blocks(v)

    i = jnp.arange(MOBA_BLOCK)
    rel = i[:, None] - i[None, :]
    bias_own = jnp.transpose(rel_table[rel_bucket(rel)], (2, 0, 1))
    logits = jnp.einsum("bhnqd,bhnkd->bhnqk", qb, kb, preferred_element_type=jnp.float32) * scale + bias_own[:, None]
    p, m, s = masked_stats(logits, rel >= 0)
    o_own = jnp.einsum("bhnqk,bhnkd->bhnqd", p.astype(vb.dtype), vb,
                       preferred_element_type=jnp.float32) / jnp.maximum(s, TINY)

    def unblock(t):
        return t.reshape(b, H, nblk * MOBA_BLOCK, t.shape[-1])[:, :, :S]

    parts = [(unblock(o_own), unblock(m), unblock(s))]

    k_top = min(MOBA_TOPK, nblk - 1)
    if k_top > 0:
        k_mean = jnp.mean(kb, axis=3)
        gate = jnp.einsum("bhsd,bhnd->bhsn", q, k_mean, preferred_element_type=jnp.float32)
        qpos = jnp.arange(S)
        past = jnp.arange(nblk)[None, :] < (qpos // MOBA_BLOCK)[:, None]
        top_val, top_idx = lax.top_k(jnp.where(past, gate, NEG_INF), k_top)
        top_valid = top_val > 0.5 * NEG_INF
        b_i = jnp.arange(b)[:, None, None, None]
        h_i = jnp.arange(H)[None, :, None, None]
        tab = rel_table.T
        C = GATHER_CHUNK

        def sel_chunk(args):
            qc, idx, valid, pos = args
            kg = kb[b_i, h_i, idx].reshape(b, H, C, k_top * MOBA_BLOCK, dh)
            vg = vb[b_i, h_i, idx].reshape(b, H, C, k_top * MOBA_BLOCK, dh)
            kpos = (idx[..., None] * MOBA_BLOCK + jnp.arange(MOBA_BLOCK)).reshape(b, H, C, k_top * MOBA_BLOCK)
            bias = tab[h_i, rel_bucket(pos[:, None] - kpos)]
            mask = jnp.repeat(valid, MOBA_BLOCK, axis=-1)
            lg = jnp.einsum("bhqd,bhqkd->bhqk", qc, kg, preferred_element_type=jnp.float32) * scale + bias
            pp, mm, ss = masked_stats(lg, mask)
            oo = jnp.einsum("bhqk,bhqkd->bhqd", pp.astype(vg.dtype), vg,
                            preferred_element_type=jnp.float32) / jnp.maximum(ss, TINY)
            return oo, mm, ss

        o_sel, m_sel, s_sel = lax.map(sel_chunk, (split_chunks(q, 2, C), split_chunks(top_idx, 2, C),
                                                  split_chunks(top_valid, 2, C), split_chunks(qpos, 0, C)))
        parts.append((merge_chunks(o_sel, 2), merge_chunks(m_sel, 2), merge_chunks(s_sel, 2)))

    o = combine_by_denominators(parts)
    return o.transpose(0, 2, 1, 3).reshape(b, S, D_MODEL)


def setup_inputs(seed: int = 0) -> dict:
    key = jax.random.key(seed)
    ks = jax.random.split(key, 17)
    f32 = jnp.float32
    nrm = lambda k, shape, scale: jax.random.normal(k, shape, f32) * scale
    return {
        "x": jax.random.normal(ks[0], (BATCH, SEQ, D_MODEL), f32),
        "rel_table": nrm(ks[1], (REL_BUCKETS, N_HEADS), 0.5),
        "attn_norm": 1.0 + nrm(ks[2], (DEPTH, D_MODEL), 0.02),
        "mlp_norm": 1.0 + nrm(ks[3], (DEPTH, D_MODEL), 0.02),
        "q_gain": 1.0 + nrm(ks[4], (DEPTH, HEAD_DIM), 0.02),
        "k_gain": 1.0 + nrm(ks[5], (DEPTH, HEAD_DIM), 0.02),
        "w_out": nrm(ks[6], (DEPTH, D_MODEL, D_MODEL), D_MODEL ** -0.5),
        "mlp_w_up": nrm(ks[7], (DEPTH, D_MODEL, D_FF), D_MODEL ** -0.5),
        "mlp_w_down": nrm(ks[8], (DEPTH, D_FF, D_MODEL), D_FF ** -0.5),
        "dsa_w_in": nrm(ks[9], (N_REPEATS, D_MODEL, 3 * D_MODEL), D_MODEL ** -0.5),
        "nsa_w_in": nrm(ks[10], (N_REPEATS, D_MODEL, NSA_IN_DIM), D_MODEL ** -0.5),
        "nsa_cmp_pos": nrm(ks[11], (N_REPEATS, 2, CMP_BLOCK, HEAD_DIM), 0.1),
        "nsa_cmp_w1": nrm(ks[12], (N_REPEATS, 2, CMP_BLOCK * HEAD_DIM, CMP_HIDDEN), (CMP_BLOCK * HEAD_DIM) ** -0.5),
        "nsa_cmp_w2": nrm(ks[13], (N_REPEATS, 2, CMP_HIDDEN, HEAD_DIM), CMP_HIDDEN ** -0.5),
        "fox_w_in": nrm(ks[14], (N_REPEATS, D_MODEL, FOX_IN_DIM), D_MODEL ** -0.5),
        "fox_b_f": jax.random.uniform(ks[15], (N_REPEATS, N_HEADS), f32, 1.0, 6.0),
        "moba_w_in": nrm(ks[16], (N_REPEATS, D_MODEL, 3 * D_MODEL), D_MODEL ** -0.5),
    }


def reference(x, rel_table, attn_norm, mlp_norm, q_gain, k_gain, w_out, mlp_w_up, mlp_w_down,
              dsa_w_in, nsa_w_in, nsa_cmp_pos, nsa_cmp_w1, nsa_cmp_w2, fox_w_in, fox_b_f, moba_w_in):
    for layer in range(DEPTH):
        kind = layer % N_MIXERS
        r = layer // N_MIXERS
        h = rmsnorm(x, attn_norm[layer])
        if kind == 0:
            mixed = dilated_mixer(h, dsa_w_in[r], q_gain[layer], k_gain[layer], rel_table)
        elif kind == 1:
            mixed = nsa_mixer(h, nsa_w_in[r], nsa_cmp_pos[r], nsa_cmp_w1[r], nsa_cmp_w2[r],
                              q_gain[layer], k_gain[layer], rel_table)
        elif kind == 2:
            mixed = fox_mixer(h, fox_w_in[r], fox_b_f[r], q_gain[layer], k_gain[layer])
        else:
            mixed = moba_mixer(h, moba_w_in[r], q_gain[layer], k_gain[layer], rel_table)
        x = x + mixed.astype(x.dtype) @ w_out[layer]
        h = rmsnorm(x, mlp_norm[layer])
        x = x + jnp.square(jax.nn.relu(h @ mlp_w_up[layer])) @ mlp_w_down[layer]
    return x
```

```cpp
#include <hip/hip_runtime.h>
#include <hip/hip_cooperative_groups.h>
#include <cstdio>
#include <cstdint>
#include <cmath>
namespace cg = cooperative_groups;

constexpr int BATCH = 4, SEQ = 4096, DM = 1024, NH = 16, HD = 64, FF = 4096, MTOK = BATCH * SEQ;
constexpr float RMS_EPS = 1e-6f;
constexpr float LOG2E = 1.4426950408889634f;
constexpr float C2 = 0.125f * LOG2E;
constexpr int NSA_N = 2608, NSA_NP = 2816;
constexpr int FOX_LDW = 3088;

#define LAS __attribute__((address_space(3)))

__device__ __forceinline__ float shx(float v, int m, int lane) { return __int_as_float(__builtin_amdgcn_ds_bpermute((lane ^ m) << 2, __float_as_int(v))); }
__device__ __forceinline__ float opaque_zero() { int z = 0; asm volatile("" : "+v"(z)); return __int_as_float(z); }

__device__ __forceinline__ int lane_id_v() { int l; asm volatile("v_mbcnt_lo_u32_b32 %0, -1, 0\n\tv_mbcnt_hi_u32_b32 %0, -1, %0" : "=v"(l)); return l; }

namespace pg8 {
#define PG8_LAS __attribute__((address_space(3)))
typedef unsigned short bf16_t;
typedef short bf16x8 __attribute__((ext_vector_type(8)));
typedef float f32x4 __attribute__((ext_vector_type(4)));
typedef unsigned u32x4 __attribute__((ext_vector_type(4)));
constexpr int BM = 256, BK = 64, HALF = 128, HTB = HALF * BK * 2  , STAGE_BYTES = 8 * HTB, NXCD = 8, WGM = 8;

__host__ __device__ __forceinline__ int lds_byte(int r, int c) { const int st = (r >> 4) * 2 + (c >> 5), rr = r & 15, cc = c & 31, ob = rr * 64 + cc * 2; return st * 1024 + (ob ^ (((ob >> 9) & 1) << 5)); }
__host__ __device__ __forceinline__ void stage_rc(int b, int& R, int& C) { const int st = b / 1024, sb = b % 1024, swz = sb ^ (((sb >> 9) & 1) << 5); R = (st >> 1) * 16 + swz / 64; C = (st & 1) * 32 + (swz % 64) / 2; }
__host__ __device__ __forceinline__ int perm32(int rho) { const int n = rho >> 4, i = rho & 15; return 8 * (i >> 2) + 4 * n + (i & 3); }

struct Unit { int pm, pn; };
struct Gemm { const bf16_t* A; const bf16_t* Bt; int M, N, K, lda; int ablk; };

struct StaticOrder {
    int nM, nN, nwg, G, c;
    __host__ __device__ void init(int M, int N, int G_, int c_) { nM = M / BM; nN = N / BM; nwg = nM * nN; G = G_; c = c_; }
    __host__ __device__ __forceinline__ bool next(int i, Unit& u) const {
        const long L = (long)i * G + c; if (L >= nwg) return false;
        int wgid = (int)L; { const int q = nwg / NXCD, r = nwg % NXCD, xcd = wgid % NXCD, off = wgid / NXCD; wgid = (xcd < r ? xcd * (q + 1) : r * (q + 1) + (xcd - r) * q) + off; }
        const int nig = WGM * nN, gid = wgid / nig, fm = gid * WGM, gsz = (nM - fm) < WGM ? (nM - fm) : WGM;
        u.pm = fm + ((wgid % nig) % gsz); u.pn = (wgid % nig) / gsz; return true;
    }
    __device__ __forceinline__ void a_ready(const Unit&) const {}
    __device__ __forceinline__ void done(const Unit&) const {}
};


__device__ __forceinline__ unsigned cvt_pk_bf16(float lo, float hi) { unsigned r; asm volatile("v_cvt_pk_bf16_f32 %0, %1, %2" : "=v"(r) : "v"(lo), "v"(hi)); return r; }
__device__ __forceinline__ float hsum4(const f32x4 v) { return (v[0] + v[1]) + (v[2] + v[3]); }
__device__ __forceinline__ float hsq4(const f32x4 v) { return (v[0] * v[0] + v[1] * v[1]) + (v[2] * v[2] + v[3] * v[3]); }
__device__ __forceinline__ float row_rstd(const float* rss, int row) {
    const f32x4* rp = (const f32x4*)(rss + (size_t)row * 16);
    const f32x4 s0 = rp[0], s1 = rp[1], s2 = rp[2], s3 = rp[3];
    const float tot = (hsum4(s0) + hsum4(s1)) + (hsum4(s2) + hsum4(s3));
    return rsqrtf(tot * (1.0f / 1024.0f) + RMS_EPS);
}
struct EpiIn {
    static constexpr bool PERM = true, AFTER_DRAIN = false;
    bf16_t* O; int ldc; const PG8_LAS float* rstdL; const PG8_LAS float* qg; const PG8_LAS float* kg; unsigned long long modes;
    bf16_t* slab0; bf16_t* slab1; int slab_tile0; float* kmean;
    unsigned long long dk, isel, ih0; int hpb; bf16_t* iA; bf16_t* iB; bf16_t* iC; bf16_t* iD; bf16_t* gates;
    __device__ __forceinline__ void operator()(const f32x4 (&acc)[2][2][4][2], const Unit& u, int ui, int wr, int wc, int fr, int fq) const {
        const int mode = (int)((modes >> (2 * u.pn)) & 3ull);
        const int dkind = (int)((dk >> (3 * u.pn)) & 7ull);
        const int row0 = u.pm * BM + wr * 64 + fr;
        const int tcol = u.pn * BM + wc * 64 + 8 * fq;
        const bool nrm = (mode == 1 || mode == 2);
        f32x4 gv[2][2];
#pragma unroll
        for (int bj = 0; bj < 2; ++bj)
#pragma unroll
            for (int n = 0; n < 2; ++n) gv[bj][n] = (f32x4){1.f, 1.f, 1.f, 1.f};
        if (nrm) { const PG8_LAS float* gp = (mode == 1) ? qg : kg; const float sc = (mode == 1) ? C2 : 1.f;
#pragma unroll
            for (int bj = 0; bj < 2; ++bj)
#pragma unroll
                for (int n = 0; n < 2; ++n) gv[bj][n] = *(const PG8_LAS f32x4*)(gp + bj * 32 + 8 * fq + 4 * n) * sc; }
        const bool km = (kmean != nullptr) && (mode == 2);
        f32x4 cs[2][2];
#pragma unroll
        for (int bj = 0; bj < 2; ++bj)
#pragma unroll
            for (int n = 0; n < 2; ++n) cs[bj][n] = (f32x4){0.f, 0.f, 0.f, 0.f};
#pragma unroll
        for (int ai = 0; ai < 2; ++ai) {
            float rs4[4];
#pragma unroll
            for (int m = 0; m < 4; ++m) rs4[m] = rstdL[ui * 256 + ai * HALF + wr * 64 + m * 16 + fr];
            if (nrm) {
                float ss4[4], t4[4]; const int ln_ = fq * 16 + fr;
#pragma unroll
                for (int m = 0; m < 4; ++m) { const float rstd = rs4[m];
                    const f32x4 a0 = acc[ai][0][m][0] * rstd, a1 = acc[ai][0][m][1] * rstd, a2 = acc[ai][1][m][0] * rstd, a3 = acc[ai][1][m][1] * rstd;
                    ss4[m] = (hsq4(a0) + hsq4(a1)) + (hsq4(a2) + hsq4(a3)); }
#pragma unroll
                for (int m = 0; m < 4; ++m) t4[m] = shx(ss4[m], 16, ln_);
#pragma unroll
                for (int m = 0; m < 4; ++m) ss4[m] += t4[m];
#pragma unroll
                for (int m = 0; m < 4; ++m) t4[m] = shx(ss4[m], 32, ln_);
#pragma unroll
                for (int m = 0; m < 4; ++m) rs4[m] *= rsqrtf((ss4[m] + t4[m]) * (1.0f / 64.0f) + RMS_EPS);
            }
#pragma unroll
            for (int m = 0; m < 4; ++m) {
                const int row = row0 + ai * HALF + m * 16;
                const float rstd = rs4[m];
                f32x4 v[2][2];
#pragma unroll
                for (int bj = 0; bj < 2; ++bj)
#pragma unroll
                    for (int n = 0; n < 2; ++n) v[bj][n] = acc[ai][bj][m][n] * rstd * gv[bj][n];
                if (km) {
#pragma unroll
                    for (int bj = 0; bj < 2; ++bj)
#pragma unroll
                        for (int n = 0; n < 2; ++n) cs[bj][n] += v[bj][n];
                }
                u32x4 wA, wB;
                wA.x = cvt_pk_bf16(v[0][0][0], v[0][0][1]); wA.y = cvt_pk_bf16(v[0][0][2], v[0][0][3]); wA.z = cvt_pk_bf16(v[0][1][0], v[0][1][1]); wA.w = cvt_pk_bf16(v[0][1][2], v[0][1][3]);
                wB.x = cvt_pk_bf16(v[1][0][0], v[1][0][1]); wB.y = cvt_pk_bf16(v[1][0][2], v[1][0][3]); wB.z = cvt_pk_bf16(v[1][1][0], v[1][1][1]); wB.w = cvt_pk_bf16(v[1][1][2], v[1][1][3]);
                if (dkind == 0) {
                u32x4 xB, yA;
#pragma unroll
                for (int k = 0; k < 4; ++k) { xB[k] = (unsigned)__builtin_amdgcn_update_dpp(0, (int)wB[k], 0x128, 0xf, 0xf, false); yA[k] = (unsigned)__builtin_amdgcn_update_dpp(0, (int)wA[k], 0x128, 0xf, 0xf, false); }
                const bool up = fr >= 8;
                const u32x4 d1 = up ? xB : wA, d2 = up ? wB : yA;
                const int rbase = row - fr + (fr & 7);
                bf16_t* p1; bf16_t* p2;
                if (mode == 3) { bf16_t* sb = (u.pn == slab_tile0) ? slab0 : slab1; const int b = rbase / SEQ, t = rbase % SEQ;
                    p1 = sb + ((size_t)((b * 4 + wc) * SEQ + t)) * 64 + 8 * fq + (up ? 32 : 0); p2 = p1 + 8 * 64; }
                else { p1 = O + (size_t)rbase * ldc + tcol + (up ? 32 : 0); p2 = p1 + (size_t)8 * ldc; }
                *(u32x4*)p1 = d1; *(u32x4*)p2 = d2;
                } else if (dkind == 4) {
                    if (wc == 0) { bf16_t* p = gates + (size_t)row * 64 + 8 * fq; *(u32x4*)p = wA; *(u32x4*)(p + 32) = wB; }
                } else {
                    const int b = row / SEQ, t = row % SEQ;
                    const int is_ = (int)((isel >> (3 * u.pn)) & 7ull), h0_ = (int)((ih0 >> (4 * u.pn)) & 15ull);
                    bf16_t* ib = is_ == 0 ? iA : (is_ == 1 ? iB : (is_ == 2 ? iC : iD));
                    bf16_t* tb = ib + ((size_t)((b * hpb + (u.pn - h0_) * 4 + wc) * 64 + (t >> 6))) * 4096;
                    bf16_t* pA = (dkind == 1) ? tb + fq * 512 + (t & 63) * 8 : tb + m * 512 + fr * 32 + fq * 8;
                    *(u32x4*)pA = wA; *(u32x4*)(pA + 4 * 512) = wB;
                }
            }
        }
        if (km) {
            const int b = u.pm / 16, blk = u.pm % 16, h = (u.pn - 4) * 4 + wc;
            float* kp = kmean + ((size_t)((b * 16 + h) * 16 + blk)) * 64 + 8 * fq;
#pragma unroll
            for (int bj = 0; bj < 2; ++bj)
#pragma unroll
                for (int n = 0; n < 2; ++n)
#pragma unroll
                    for (int i = 0; i < 4; ++i) { float s = cs[bj][n][i];
                        { const int ln_ = fq * 16 + fr; s += shx(s, 1, ln_); s += shx(s, 2, ln_); s += shx(s, 4, ln_); s += shx(s, 8, ln_); }
                        if (fr == 0) atomicAdd(kp + bj * 32 + 4 * n + i, s); }
        }
    }
};
template <bool BASE_F32, bool OUT_F32> struct EpiRes {
    static constexpr bool PERM = true, AFTER_DRAIN = false;
    const float* base32; float* out32; bf16_t* xb; float* rss_out;
    __device__ __forceinline__ void operator()(const f32x4 (&acc)[2][2][4][2], const Unit& u, int ui, int wr, int wc, int fr, int fq) const {
        const int row0 = u.pm * BM + wr * 64 + fr, col0 = u.pn * BM + wc * 32 + 8 * fq;
        u32x4 raw[2][4][2];
        if (!BASE_F32) {
#pragma unroll
            for (int ai = 0; ai < 2; ++ai)
#pragma unroll
                for (int m = 0; m < 4; ++m)
#pragma unroll
                    for (int bj = 0; bj < 2; ++bj) { const size_t offb = (size_t)((u.pm * 16 + wr * 4 + ai * 8 + m) * (DM / 32) + (u.pn * 8 + bj * 4 + wc)) * 512 + fr * 32 + 8 * fq;
                        raw[ai][m][bj] = *(const u32x4*)(xb + offb); }
        }
#pragma unroll
        for (int ai = 0; ai < 2; ++ai) {
            f32x4 pre[4][2][2];
#pragma unroll
            for (int m = 0; m < 4; ++m)
#pragma unroll
                for (int bj = 0; bj < 2; ++bj) { const size_t off = (size_t)(row0 + ai * HALF + m * 16) * DM + col0 + bj * HALF;
                    if (BASE_F32) { pre[m][bj][0] = *(const f32x4*)(base32 + off); pre[m][bj][1] = *(const f32x4*)(base32 + off + 4); }
                    else { const u32x4 w = raw[ai][m][bj];
                        pre[m][bj][0] = (f32x4){__uint_as_float(w.x << 16), __uint_as_float(w.x & 0xffff0000u), __uint_as_float(w.y << 16), __uint_as_float(w.y & 0xffff0000u)};
                        pre[m][bj][1] = (f32x4){__uint_as_float(w.z << 16), __uint_as_float(w.z & 0xffff0000u), __uint_as_float(w.w << 16), __uint_as_float(w.w & 0xffff0000u)}; } }
#pragma unroll
            for (int m = 0; m < 4; ++m) {
                const int row = row0 + ai * HALF + m * 16; float ss = 0.f;
#pragma unroll
                for (int bj = 0; bj < 2; ++bj) { const size_t off = (size_t)row * DM + col0 + bj * HALF;
                    const size_t offb = (size_t)((u.pm * 16 + wr * 4 + ai * 8 + m) * (DM / 32) + (u.pn * 8 + bj * 4 + wc)) * 512 + fr * 32 + 8 * fq;
                    const f32x4 v0 = acc[ai][bj][m][0] + pre[m][bj][0], v1 = acc[ai][bj][m][1] + pre[m][bj][1];
                    if (OUT_F32) { *(f32x4*)(out32 + off) = v0; *(f32x4*)(out32 + off + 4) = v1; }
                    else { u32x4 w; w.x = cvt_pk_bf16(v0[0], v0[1]); w.y = cvt_pk_bf16(v0[2], v0[3]); w.z = cvt_pk_bf16(v1[0], v1[1]); w.w = cvt_pk_bf16(v1[2], v1[3]);
                        *(u32x4*)(xb + offb) = w; }
                    ss += hsq4(v0) + hsq4(v1); }
                if (!OUT_F32) { ss += shx(ss, 16, fq * 16 + fr); ss += shx(ss, 32, fq * 16 + fr);
                    if (fq == 0) rss_out[(size_t)row * 16 + u.pn * 4 + wc] = ss; }
            }
        }
    }
};
template <class Sched> __device__ __forceinline__ void rstd_prepass(const Sched& S, const float* rss, PG8_LAS float* rstdL, int tid) {
    Unit u;
    for (int i = 0; S.next(i, u); ++i) if (tid < 256) rstdL[i * 256 + tid] = row_rstd(rss, u.pm * BM + tid);
}
struct EpiUp {
    static constexpr bool PERM = true, AFTER_DRAIN = false;
    bf16_t* O; const PG8_LAS float* rstdL;
    __device__ __forceinline__ void operator()(const f32x4 (&acc)[2][2][4][2], const Unit& u, int ui, int wr, int wc, int fr, int fq) const {
        const int row0 = u.pm * BM + wr * 64 + fr, col0 = u.pn * BM + wc * 32 + 8 * fq;
#pragma unroll
        for (int ai = 0; ai < 2; ++ai)
#pragma unroll
            for (int m = 0; m < 4; ++m) {
                const int row = row0 + ai * HALF + m * 16; const float rstd = rstdL[ui * 256 + ai * HALF + wr * 64 + m * 16 + fr];
#pragma unroll
                for (int bj = 0; bj < 2; ++bj) { f32x4 v0 = acc[ai][bj][m][0] * rstd, v1 = acc[ai][bj][m][1] * rstd;
#pragma unroll
                    for (int i = 0; i < 4; ++i) { const float a = fmaxf(v0[i], 0.f), b = fmaxf(v1[i], 0.f); v0[i] = a * a; v1[i] = b * b; }
                    u32x4 w; w.x = cvt_pk_bf16(v0[0], v0[1]); w.y = cvt_pk_bf16(v0[2], v0[3]); w.z = cvt_pk_bf16(v1[0], v1[1]); w.w = cvt_pk_bf16(v1[2], v1[3]);
                    *(u32x4*)(O + ((size_t)((u.pm * 16 + wr * 4 + ai * 8 + m) * (FF / 32) + (u.pn * 8 + bj * 4 + wc)) * 512 + fr * 32 + 8 * fq)) = w; }
            }
    }
};
__device__ __forceinline__ float gelu_tanh(float x) {
    const float u = 0.7978845608028654f * (x + 0.044715f * x * x * x);
    const float e = __expf(2.f * u);
    const float th = 1.f - 2.f / (e + 1.f);
    return 0.5f * x * (1.f + th);
}
struct EpiCmp {
    static constexpr bool PERM = true, AFTER_DRAIN = false;
    bf16_t* O; const float* posb;
    __device__ __forceinline__ void operator()(const f32x4 (&acc)[2][2][4][2], const Unit& u, int ui, int wr, int wc, int fr, int fq) const {
        const int row0 = u.pm * BM + wr * 64 + fr, col0 = wc * 32 + 8 * fq;
        f32x4 bv[2][2];
#pragma unroll
        for (int bj = 0; bj < 2; ++bj)
#pragma unroll
            for (int n = 0; n < 2; ++n) bv[bj][n] = *(const f32x4*)(posb + col0 + bj * HALF + 4 * n);
#pragma unroll
        for (int ai = 0; ai < 2; ++ai)
#pragma unroll
            for (int m = 0; m < 4; ++m) {
                const int row = row0 + ai * HALF + m * 16;
#pragma unroll
                for (int bj = 0; bj < 2; ++bj) { f32x4 v0 = acc[ai][bj][m][0] + bv[bj][0], v1 = acc[ai][bj][m][1] + bv[bj][1];
#pragma unroll
                    for (int i = 0; i < 4; ++i) { v0[i] = gelu_tanh(v0[i]); v1[i] = gelu_tanh(v1[i]); }
                    u32x4 w; w.x = cvt_pk_bf16(v0[0], v0[1]); w.y = cvt_pk_bf16(v0[2], v0[3]); w.z = cvt_pk_bf16(v1[0], v1[1]); w.w = cvt_pk_bf16(v1[2], v1[3]);
                    *(u32x4*)(O + (size_t)row * 256 + col0 + bj * HALF) = w; }
            }
    }
};

struct NoPre { __device__ __forceinline__ void operator()(int) const {} };
template <class Epi, class Sched, bool ALIGN_EPI = false, bool SP2 = false, class Pre = NoPre>
__device__ __forceinline__ void gemm_phase(PG8_LAS unsigned char* lds, const Gemm g, const Sched& S, const Epi& E, const int wave_s, const Pre& pre = Pre()) {
    int wid_l = wave_s; asm volatile("" : "+s"(wid_l));
    const int lane = lane_id_v(), wid = wid_l, tid = wid * 64 + lane, wr = wid >> 2, wc = wid & 3, fr = lane & 15, fq = lane >> 4;
    const int K = g.K, nt = K / BK;
    unsigned voffA[2], voffB[2];
#pragma unroll
    for (int i = 0; i < 2; ++i) { int R, C; stage_rc(tid * 16 + i * 8192, R, C); const int Rb = Epi::PERM ? ((R & ~31) + perm32(R & 31)) : R;
        voffA[i] = g.ablk ? (unsigned)((R >> 4) * (K / 32) * 1024 + (R & 15) * 64 + (C >> 5) * 1024 + (C & 31) * 2) : (unsigned)(R * g.lda + C) * 2u;   voffB[i] = (unsigned)((Rb >> 4) * (K / 32) * 1024 + (Rb & 15) * 64 + (C >> 5) * 1024 + (C & 31) * 2); }
    const size_t kstepB = (size_t)2048, kstepA = g.ablk ? (size_t)2048 : (size_t)(BK * 2);
    const size_t hstepA = (size_t)HALF * g.lda * 2, hstepB = (size_t)HALF * K * 2;
    const size_t tstepA = 2 * hstepA, tstepB = 2 * hstepB;
    const unsigned ldsw = (unsigned)wid * 1024u;
    const int aoff = lds_byte(wr * 64 + fr, fq * 8), boff = lds_byte(wc * 32 + fr, fq * 8);
#define PG8_SA(b, h) (((b) * 2 + (h)) * HTB)
#define PG8_SB(b, h) ((4 + (b) * 2 + (h)) * HTB)
#define PG8_STAGE(bufoff, gbase, voff) do { _Pragma("unroll") for (int _i = 0; _i < 2; ++_i) \
        __builtin_amdgcn_global_load_lds((const unsigned*)((const char*)(gbase) + (voff)[_i]), (PG8_LAS unsigned*)(lds + (bufoff) + ldsw + _i * 8192), 16, 0, 0); } while (0)
#define PG8_LDA(dst, b, h) do { _Pragma("unroll") for (int m = 0; m < 4; ++m) _Pragma("unroll") for (int k = 0; k < 2; ++k) dst[m][k] = *(const PG8_LAS bf16x8*)(lds + PG8_SA(b, h) + aoff + m * 2048 + k * 1024); } while (0)
#define PG8_LDB(dst, b, h) do { _Pragma("unroll") for (int n = 0; n < 2; ++n) _Pragma("unroll") for (int k = 0; k < 2; ++k) dst[n][k] = *(const PG8_LAS bf16x8*)(lds + PG8_SB(b, h) + boff + n * 2048 + k * 1024); } while (0)
#define PG8_MMA(ai, bj, At, Bt) do { __builtin_amdgcn_s_setprio(1); _Pragma("unroll") for (int m = 0; m < 4; ++m) _Pragma("unroll") for (int n = 0; n < 2; ++n) _Pragma("unroll") for (int k = 0; k < 2; ++k) \
        acc[ai][bj][m][n] = __builtin_amdgcn_mfma_f32_16x16x32_bf16(Bt[n][k], At[m][k], acc[ai][bj][m][n], 0, 0, 0); __builtin_amdgcn_s_setprio(0); } while (0)
#define PG8_WAIT_V(n) asm volatile("s_waitcnt vmcnt(" #n ")" ::: "memory")
#define PG8_WAIT_L(n) asm volatile("s_waitcnt lgkmcnt(" #n ")" ::: "memory")
#define PG8_BAR __builtin_amdgcn_s_barrier()
#define PG8_SCHED __builtin_amdgcn_sched_barrier(0)
    Unit cur, nxt; int ui = 0;
    if (!S.next(0, cur)) return;
    f32x4 acc[2][2][4][2]; float zq_ = opaque_zero();
#pragma unroll
    for (int a = 0; a < 2; ++a)
#pragma unroll
        for (int b = 0; b < 2; ++b)
#pragma unroll
            for (int m = 0; m < 4; ++m)
#pragma unroll
                for (int n = 0; n < 2; ++n) acc[a][b][m][n] = (f32x4){zq_, zq_, zq_, zq_};
    bf16x8 At[4][2], B0[2][2], B1[2][2];
    const char* cA = (const char*)g.A + (size_t)cur.pm * tstepA; const char* cB = (const char*)g.Bt + (size_t)cur.pn * tstepB;
    S.a_ready(cur);
    if constexpr (SP2) {
        PG8_STAGE(PG8_SB(0, 0), cB, voffB); PG8_STAGE(PG8_SB(0, 1), cB + hstepB, voffB); PG8_STAGE(PG8_SA(0, 0), cA, voffA); PG8_STAGE(PG8_SA(0, 1), cA + hstepA, voffA);
        pre(tid);
        if (wr == 1) PG8_BAR;
        PG8_WAIT_V(2); PG8_BAR;
        PG8_STAGE(PG8_SB(1, 0), cB + kstepB, voffB); PG8_STAGE(PG8_SA(1, 0), cA + kstepA, voffA); PG8_STAGE(PG8_SB(1, 1), cB + hstepB + kstepB, voffB);
        PG8_WAIT_V(6); PG8_BAR;
    } else {
        PG8_STAGE(PG8_SB(0, 0), cB, voffB); PG8_STAGE(PG8_SA(0, 0), cA, voffA); PG8_STAGE(PG8_SB(0, 1), cB + hstepB, voffB); PG8_STAGE(PG8_SA(0, 1), cA + hstepA, voffA);
        if (wr == 1) PG8_BAR;
        PG8_WAIT_V(4); PG8_BAR;
        PG8_STAGE(PG8_SB(1, 0), cB + kstepB, voffB); PG8_STAGE(PG8_SA(1, 0), cA + kstepA, voffA); PG8_STAGE(PG8_SB(1, 1), cB + hstepB + kstepB, voffB);
        PG8_WAIT_V(6); PG8_BAR;
    }
    for (;;) {
        const bool has_next = S.next(ui + 1, nxt);
        const char* nA = has_next ? (const char*)g.A + (size_t)nxt.pm * tstepA : cA; const char* nB = has_next ? (const char*)g.Bt + (size_t)nxt.pn * tstepB : cB;
        for (int t = 0; t < nt; t += 2) {
            const bool last = (t == nt - 2);
            const char* a1 = cA + (size_t)(t + 1) * kstepA;
            const char* a2 = last ? nA : cA + (size_t)(t + 2) * kstepA; const char* b2 = last ? nB : cB + (size_t)(t + 2) * kstepB;
            const char* a3 = a2 + kstepA; const char* b3 = b2 + kstepB;
            if (last && has_next) S.a_ready(nxt);
            if constexpr (SP2) {
            PG8_LDB(B0, 0, 0); PG8_LDB(B1, 0, 1); PG8_SCHED; PG8_LDA(At, 0, 0); PG8_STAGE(PG8_SA(1, 1), a1 + hstepA, voffA);
            PG8_WAIT_V(8); PG8_WAIT_L(0); PG8_BAR; PG8_MMA(0, 0, At, B0); PG8_MMA(0, 1, At, B1); PG8_BAR; PG8_SCHED;
            PG8_LDA(At, 0, 1); PG8_STAGE(PG8_SB(0, 0), b2, voffB); PG8_STAGE(PG8_SB(0, 1), b2 + hstepB, voffB); PG8_STAGE(PG8_SA(0, 0), a2, voffA);
            PG8_WAIT_V(8); PG8_WAIT_L(0); PG8_BAR; PG8_MMA(1, 0, At, B0); PG8_MMA(1, 1, At, B1); PG8_BAR; PG8_SCHED;
            PG8_LDB(B0, 1, 0); PG8_LDB(B1, 1, 1); PG8_SCHED; PG8_LDA(At, 1, 0); PG8_STAGE(PG8_SA(0, 1), a2 + hstepA, voffA);
            PG8_WAIT_V(8); PG8_WAIT_L(0); PG8_BAR; PG8_MMA(0, 0, At, B0); PG8_MMA(0, 1, At, B1); PG8_BAR; PG8_SCHED;
            PG8_LDA(At, 1, 1); PG8_STAGE(PG8_SB(1, 0), b3, voffB); PG8_STAGE(PG8_SB(1, 1), b3 + hstepB, voffB); PG8_STAGE(PG8_SA(1, 0), a3, voffA);
            PG8_WAIT_V(8); PG8_WAIT_L(0); PG8_BAR; PG8_MMA(1, 0, At, B0); PG8_MMA(1, 1, At, B1); PG8_BAR; PG8_SCHED;
            } else {
            PG8_LDB(B0, 0, 0); PG8_SCHED; PG8_LDA(At, 0, 0); PG8_STAGE(PG8_SA(1, 1), a1 + hstepA, voffA);
            PG8_WAIT_L(8); PG8_BAR; PG8_WAIT_L(0); PG8_MMA(0, 0, At, B0); PG8_BAR; PG8_SCHED;
            PG8_LDB(B1, 0, 1); PG8_STAGE(PG8_SB(0, 0), b2, voffB);
            PG8_BAR; PG8_WAIT_L(0); PG8_MMA(0, 1, At, B1); PG8_BAR;
            PG8_LDA(At, 0, 1); PG8_STAGE(PG8_SA(0, 0), a2, voffA);
            PG8_BAR; PG8_WAIT_L(0); PG8_MMA(1, 0, At, B0); PG8_BAR; PG8_SCHED;
            PG8_STAGE(PG8_SB(0, 1), b2 + hstepB, voffB);
            PG8_WAIT_V(6); PG8_BAR; PG8_MMA(1, 1, At, B1); PG8_BAR;
            PG8_LDB(B0, 1, 0); PG8_SCHED; PG8_LDA(At, 1, 0); PG8_STAGE(PG8_SA(0, 1), a2 + hstepA, voffA);
            PG8_WAIT_L(8); PG8_BAR; PG8_WAIT_L(0); PG8_MMA(0, 0, At, B0); PG8_BAR; PG8_SCHED;
            PG8_LDB(B1, 1, 1); PG8_STAGE(PG8_SB(1, 0), b3, voffB);
            PG8_BAR; PG8_WAIT_L(0); PG8_MMA(0, 1, At, B1); PG8_BAR;
            PG8_LDA(At, 1, 1); PG8_STAGE(PG8_SA(1, 0), a3, voffA);
            PG8_BAR; PG8_WAIT_L(0); PG8_MMA(1, 0, At, B0); PG8_BAR; PG8_SCHED;
            PG8_STAGE(PG8_SB(1, 1), b3 + hstepB, voffB);
            PG8_WAIT_V(6); PG8_BAR; PG8_MMA(1, 1, At, B1); PG8_BAR;
            }
        }
        if constexpr (ALIGN_EPI) { if (wr == 0) PG8_BAR; }
        if constexpr (!Epi::AFTER_DRAIN) { E(acc, cur, ui, wr, wc, fr, fq); S.done(cur); }
        if (!has_next) break;
        zq_ = opaque_zero();
#pragma unroll
        for (int a = 0; a < 2; ++a)
#pragma unroll
            for (int b = 0; b < 2; ++b)
#pragma unroll
                for (int m = 0; m < 4; ++m)
#pragma unroll
                    for (int n = 0; n < 2; ++n) acc[a][b][m][n] = (f32x4){zq_, zq_, zq_, zq_};
        cur = nxt; cA = nA; cB = nB; ++ui;
        if constexpr (ALIGN_EPI) { if (wr == 1) PG8_BAR; }
    }
    PG8_WAIT_V(0);
    if constexpr (!ALIGN_EPI) { if (wr == 0) PG8_BAR; }
    PG8_BAR;
    if constexpr (Epi::AFTER_DRAIN) { E.fused(acc, cur, wr, wc, fr, fq, lds, wid, lane); S.done(cur); }
#undef PG8_SA
#undef PG8_SB
#undef PG8_STAGE
#undef PG8_LDA
#undef PG8_LDB
#undef PG8_MMA
#undef PG8_WAIT_V
#undef PG8_WAIT_L
#undef PG8_BAR
#undef PG8_SCHED
}
}

namespace att {
typedef unsigned short bf16;
using bf16x8 = __attribute__((ext_vector_type(8))) short;
using s16x4 = __attribute__((ext_vector_type(4))) short;
using f32x16 = __attribute__((ext_vector_type(16))) float;
using f32x4 = __attribute__((ext_vector_type(4))) float;
using u32x4 = __attribute__((ext_vector_type(4))) unsigned;
constexpr int NW = 8, QBLK = 32, QB = QBLK * NW, KVBLK = 64;
constexpr int NSLOT = 3, SLOTB = 8192;
constexpr int LDS_K = 0, LDS_V = NSLOT * SLOTB, LDS_WS = 2 * NSLOT * SLOTB, LDS_OST = LDS_WS + NW * 128 * 4, LDS_TAB = LDS_OST + NW * 4096, TABQ = 1872  , LDS_KM = LDS_TAB + TABQ * 16, LDS_END = LDS_KM + 8192;
static_assert(LDS_END <= 131072, "attention LDS map");
__device__ __forceinline__ int crow(int r, int hi) { return (r & 3) + 8 * (r >> 2) + 4 * hi; }
#define SBAR() __builtin_amdgcn_sched_barrier(0)
__device__ __forceinline__ void cmask(f32x16& p0, f32x16& p1, int jb, int qrel, int hi) {
    const float NEG = -INFINITY; int thr = qrel - (64 * jb + 4 * hi); asm volatile("" : "+v"(thr));
#pragma unroll
    for (int r = 0; r < 16; ++r) { const int c = (r & 3) + 8 * (r >> 2); if (c > thr) p0[r] = NEG; if (c + 32 > thr) p1[r] = NEG; }
}
__device__ __forceinline__ void glds16(const void* gsrc, unsigned lds_dst) { unsigned keep;
    asm volatile("s_mov_b32 %0, m0\n\ts_mov_b32 m0, %2\n\ts_nop 0\n\tglobal_load_lds_dwordx4 %1, off\n\ts_mov_b32 m0, %0" : "=&s"(keep) : "v"(gsrc), "s"(lds_dst) : "memory"); }
__device__ __forceinline__ float max3f(float a, float b, float c) { float r; asm("v_max3_f32 %0, %1, %2, %3" : "=v"(r) : "v"(a), "v"(b), "v"(c)); return r; }
__device__ __forceinline__ float max2f(float a, float b) { float r; asm("v_max_f32_e32 %0, %1, %2" : "=v"(r) : "v"(a), "v"(b)); return r; }
__device__ __forceinline__ float fadd_s(float a, float b) { float r; asm("v_add_f32_e32 %0, %1, %2" : "=v"(r) : "v"(a), "v"(b)); return r; }
__device__ __forceinline__ float fsub_s(float a, float b) { float r; asm("v_sub_f32_e32 %0, %1, %2" : "=v"(r) : "v"(a), "v"(b)); return r; }
typedef float f32x2_t __attribute__((ext_vector_type(2))); typedef __bf16 bf16x2_t __attribute__((ext_vector_type(2)));
__device__ __forceinline__ unsigned cvtpk_s(float lo, float hi) { f32x2_t v = {lo, hi}; bf16x2_t b = __builtin_convertvector(v, bf16x2_t); return __builtin_bit_cast(unsigned, b); }
__device__ __forceinline__ float bflo(unsigned u) { return __uint_as_float(u << 16); }
__device__ __forceinline__ float bfhi(unsigned u) { return __uint_as_float(u & 0xffff0000u); }
#define WAIT_BAR(N) asm volatile("s_waitcnt vmcnt(" #N ") lgkmcnt(0)\n\ts_barrier" ::: "memory")

__device__ __forceinline__ void qkt(f32x16& p0, f32x16& p1, const char* Kslot, const bf16x8* qr, const f32x16& negm, int r32, int hi) {
    const char* kb = Kslot + hi * 1024 + r32 * 16;
#pragma unroll
    for (int d0 = 0; d0 < 4; ++d0) {
        const bf16x8 b0 = *reinterpret_cast<const bf16x8*>(kb + d0 * 2048);
        const bf16x8 b1 = *reinterpret_cast<const bf16x8*>(kb + d0 * 2048 + 512);
        if (d0 == 0) { p0 = __builtin_amdgcn_mfma_f32_32x32x16_bf16(b0, qr[0], negm, 0, 0, 0); p1 = __builtin_amdgcn_mfma_f32_32x32x16_bf16(b1, qr[0], negm, 0, 0, 0); }
        else { p0 = __builtin_amdgcn_mfma_f32_32x32x16_bf16(b0, qr[d0], p0, 0, 0, 0); p1 = __builtin_amdgcn_mfma_f32_32x32x16_bf16(b1, qr[d0], p1, 0, 0, 0); } }
}
__device__ __forceinline__ void qkt_acc(f32x16& p0, f32x16& p1, const char* Kslot, const bf16x8* qr, int r32, int hi) {
    const char* kb = Kslot + hi * 1024 + r32 * 16;
#pragma unroll
    for (int d0 = 0; d0 < 4; ++d0) {
        const bf16x8 b0 = *reinterpret_cast<const bf16x8*>(kb + d0 * 2048);
        const bf16x8 b1 = *reinterpret_cast<const bf16x8*>(kb + d0 * 2048 + 512);
        p0 = __builtin_amdgcn_mfma_f32_32x32x16_bf16(b0, qr[d0], p0, 0, 0, 0); p1 = __builtin_amdgcn_mfma_f32_32x32x16_bf16(b1, qr[d0], p1, 0, 0, 0); }
}
typedef __attribute__((address_space(3))) const char* lds_cptr;
typedef short v4i16_t __attribute__((ext_vector_type(4)));
__device__ __forceinline__ void kload8(bf16x8* kf, lds_cptr kp) {
    kf[0] = *(const LAS bf16x8*)(kp);        kf[1] = *(const LAS bf16x8*)(kp + 512);
    kf[2] = *(const LAS bf16x8*)(kp + 2048); kf[3] = *(const LAS bf16x8*)(kp + 2560);
    kf[4] = *(const LAS bf16x8*)(kp + 4096); kf[5] = *(const LAS bf16x8*)(kp + 4608);
    kf[6] = *(const LAS bf16x8*)(kp + 6144); kf[7] = *(const LAS bf16x8*)(kp + 6656);
}
__device__ __forceinline__ void kload2(bf16x8* kf, lds_cptr kp, int j) { kf[2 * j] = *(const LAS bf16x8*)(kp + j * 2048); kf[2 * j + 1] = *(const LAS bf16x8*)(kp + j * 2048 + 512); }
__device__ __forceinline__ s16x4 vtr(lds_cptr p) { return __builtin_bit_cast(s16x4, __builtin_amdgcn_ds_read_tr16_b64_v4i16((LAS v4i16_t*)p)); }
__device__ __forceinline__ float rowmax(const f32x16& p0, const f32x16& p1) {
    float a = max3f(p0[0], p0[1], p1[0]), b = max3f(p0[2], p0[3], p1[1]); a = max3f(a, p1[2], p1[3]);
#pragma unroll
    for (int r = 4; r < 16; r += 4) { a = max3f(a, p0[r], p0[r + 1]); b = max3f(b, p0[r + 2], p0[r + 3]); a = max3f(a, p1[r], p1[r + 1]); b = max3f(b, p1[r + 2], p1[r + 3]); }
    const float m = max2f(a, b);
    auto rr = __builtin_amdgcn_permlane32_swap(__float_as_uint(m), __float_as_uint(m), false, false);
    return max2f(__uint_as_float(rr[0]), __uint_as_float(rr[1]));
}
__device__ __forceinline__ void pv(f32x16* o, int vb, bf16x8 pa0, bf16x8 pa1, bf16x8 pa2, bf16x8 pa3) {
#pragma unroll
    for (int d0 = 0; d0 < 2; ++d0) { s16x4 lo[4], hi[4];
#pragma unroll
        for (int ks = 0; ks < 4; ++ks) {
            asm volatile("ds_read_b64_tr_b16 %0,%1 offset:%c2" : "=&v"(lo[ks]) : "v"(vb), "i"(d0 * 4096 + ks * 1024) : "memory");
            asm volatile("ds_read_b64_tr_b16 %0,%1 offset:%c2" : "=&v"(hi[ks]) : "v"(vb), "i"(d0 * 4096 + ks * 1024 + 512) : "memory"); }
        asm volatile("s_waitcnt lgkmcnt(0)" ::: "memory"); SBAR();
#define PK(k) (bf16x8){lo[k][0], lo[k][1], lo[k][2], lo[k][3], hi[k][0], hi[k][1], hi[k][2], hi[k][3]}
        o[d0] = __builtin_amdgcn_mfma_f32_32x32x16_bf16(pa0, PK(0), o[d0], 0, 0, 0);
        o[d0] = __builtin_amdgcn_mfma_f32_32x32x16_bf16(pa1, PK(1), o[d0], 0, 0, 0);
        o[d0] = __builtin_amdgcn_mfma_f32_32x32x16_bf16(pa2, PK(2), o[d0], 0, 0, 0);
        o[d0] = __builtin_amdgcn_mfma_f32_32x32x16_bf16(pa3, PK(3), o[d0], 0, 0, 0);
#undef PK
    }
}

enum { HK_REL = 0, HK_RELMASK = 1, HK_FOX = 2 };
constexpr float SM_REF = 6.0f;
struct UnitP {
    const bf16* Qp; const bf16* Kp; const bf16* Vp;
    long qrs, krs;
    int img;
    int q0, t_lo, NT;
    const float* tg; int W;
    int tfill, tCmax, tlen, tsh, toff;
    const float* cseq;
    const unsigned long long* mask64;
    const float* kmean; int qb;
    int mshift;
    bf16* Op; long ors;
    float* ml_out; long mls;
    const bf16* S1; const bf16* S2;
    const float* ml1; const float* ml2;
    const bf16* gate; long grs;
    int accum;
    int pre;
    const bf16* nQp; const bf16* nKp; const bf16* nVp; int nq0, ntlo, nNT, ncont;
};

template <int HOOK, int THRL, bool RES = false>
__device__ __forceinline__ void attn_unit(const UnitP& P, char* shm, const int wave_s, bf16x8 (&qr)[4], unsigned long long& mask) {
    constexpr int RSLOTS = 8;
    constexpr int L_V = RES ? RSLOTS * SLOTB : LDS_V, L_WS = RES ? 2 * RSLOTS * SLOTB : LDS_WS, L_OST = L_WS + NW * 128 * 4, L_TAB = L_OST + (RES ? 0 : NW * 4096), L_KM = RES ? L_TAB : LDS_KM;
    static_assert(!RES || (HOOK == HK_REL && L_TAB + 640 * 16 <= 147456 - 64), "resident-tile LDS map");
#define RS(t) (((P.t_lo + (t)) & (RSLOTS - 1)) * SLOTB)
#define RES_DMA(t0, t1) do { const int ln_ = lane_id_v(); \
    const bf16* ks_ = P.img ? (P.Kp + (long)P.t_lo * 4096 + wid * 512 + ln_ * 8) : (P.Kp + ((long)P.t_lo * KVBLK + ln_) * P.krs + wid * 8); \
    const bf16* vs_ = P.img ? (P.Vp + (long)P.t_lo * 4096 + wid * 512 + ln_ * 8) : (P.Vp + ((long)P.t_lo * KVBLK + 16 * (wid & 3) + (ln_ >> 2)) * P.krs + (wid >> 2) * 32 + (ln_ & 3) * 8); \
    _Pragma("unroll 1") for (int t_ = (t0); t_ < (t1); ++t_) { glds16(ks_ + (long)t_ * tstride, (unsigned)__builtin_amdgcn_readfirstlane(kdst + RS(t_))); glds16(vs_ + (long)t_ * tstride, (unsigned)__builtin_amdgcn_readfirstlane(vdst + RS(t_))); } } while (0)
    int wid_l = wave_s; asm volatile("" : "+s"(wid_l));
    const int lane = lane_id_v(), wid = wid_l, tid = wid * 64 + lane, r32 = lane & 31, hi = lane >> 5;
    const int NT = P.NT;
    constexpr bool USE_NEGM = false; constexpr bool ONLINE = false;
    const bf16* Qw = P.Qp + (long)(P.q0 + wid * QBLK) * P.qrs;
    const unsigned lds0 = (unsigned)(uintptr_t)shm;
    LAS float* wsf = (LAS float*)((LAS char*)(uintptr_t)lds0 + L_WS) + wid * 128;
    LAS float* tabL = (LAS float*)((LAS char*)(uintptr_t)lds0 + L_TAB);
    LAS float* kmL = (LAS float*)((LAS char*)(uintptr_t)lds0 + L_KM);
    const long tstride = P.img ? 4096L : (long)KVBLK * P.krs;
    const bf16* ksrc = P.img ? (P.Kp + (long)P.t_lo * 4096 + wid * 512 + lane * 8) : (P.Kp + ((long)P.t_lo * KVBLK + lane) * P.krs + wid * 8);
    const bf16* vsrc = P.img ? (P.Vp + (long)P.t_lo * 4096 + wid * 512 + lane * 8) : (P.Vp + ((long)P.t_lo * KVBLK + 16 * (wid & 3) + (lane >> 2)) * P.krs + (wid >> 2) * 32 + (lane & 3) * 8);
    const unsigned kdst = lds0 + LDS_K + wid * 1024, vdst = lds0 + L_V + wid * 1024;
#define DMA_K(t, slot) glds16(ksrc + (long)(t) * tstride, (unsigned)__builtin_amdgcn_readfirstlane(kdst + (slot)))
#define DMA_V(t, slot) glds16(vsrc + (long)(t) * tstride, (unsigned)__builtin_amdgcn_readfirstlane(vdst + (slot)))
    const int qrel = wid * QBLK + r32;
    const int vb0 = (int)(lds0 + L_V) + ((lane >> 4) & 1) * 32 + (lane & 3) * 8 + (4 * hi + ((lane & 15) >> 2)) * 64;
    const char* Kbase = shm + LDS_K; bf16x8 kf[8];
    const lds_cptr shm3 = (lds_cptr)(uintptr_t)lds0; const lds_cptr kp0 = shm3 + LDS_K + hi * 1024 + r32 * 16; const lds_cptr vp0 = shm3 + L_V + ((lane >> 4) & 1) * 32 + (lane & 3) * 8 + (4 * hi + ((lane & 15) >> 2)) * 64;
    if (!P.pre) {
    if (RES) {
        RES_DMA(0, NT);
    } else { DMA_K(0, 0); DMA_V(0, 0); DMA_K(1, SLOTB); }
#pragma unroll
    for (int d0 = 0; d0 < 4; ++d0) qr[d0] = *reinterpret_cast<const bf16x8*>(&Qw[(long)r32 * P.qrs + d0 * 16 + hi * 8]);
    }
    float mhat = 0.f, l_reg = 0.f; const float zf_ = opaque_zero(); f32x16 o[2]; f32x16 negm = f32x16{}; _Pragma("unroll") for (int r = 0; r < 16; ++r) { o[0][r] = zf_; o[1][r] = zf_; if (USE_NEGM) negm[r] = zf_; } if (USE_NEGM) asm volatile("" : "+v"(negm));
#define CINIT (USE_NEGM ? negm : f32x16{})
#define BIASLD(C0, C1, t) do { \
    if (HOOK == HK_FOX) { const LAS f32x4* cb_ = (const LAS f32x4*)tabL + (16 * (t) + hi); \
        _Pragma("unroll") for (int g_ = 0; g_ < 4; ++g_) { const f32x4 a_ = cb_[2 * g_], b_ = cb_[8 + 2 * g_]; \
            C0[4 * g_] = a_[0]; C0[4 * g_ + 1] = a_[1]; C0[4 * g_ + 2] = a_[2]; C0[4 * g_ + 3] = a_[3]; \
            C1[4 * g_] = b_[0]; C1[4 * g_ + 1] = b_[1]; C1[4 * g_ + 2] = b_[2]; C1[4 * g_ + 3] = b_[3]; } } \
    else { int j0_ = 64 * (t) + 4 * hi - qrel + 255 + P.tsh - P.toff; j0_ = j0_ < 0 ? 0 : j0_;     \
        if (HOOK == HK_RELMASK) { if (!((mask >> (((t) + P.t_lo) >> P.mshift)) & 1ull)) j0_ = P.tlen - 64; }     \
        const LAS f32x4* tb4_ = (const LAS f32x4*)tabL + j0_; \
        _Pragma("unroll") for (int g_ = 0; g_ < 4; ++g_) { const f32x4 a_ = tb4_[8 * g_], b_ = tb4_[32 + 8 * g_]; \
            C0[4 * g_] = a_[0]; C0[4 * g_ + 1] = a_[1]; C0[4 * g_ + 2] = a_[2]; C0[4 * g_ + 3] = a_[3]; \
            C1[4 * g_] = b_[0]; C1[4 * g_ + 1] = b_[1]; C1[4 * g_ + 2] = b_[2]; C1[4 * g_ + 3] = b_[3]; } } \
    } while (0)
#define POSTF(C0, C1, t) do { \
    if (HOOK == HK_FOX) { _Pragma("unroll") for (int r = 0; r < 16; ++r) { C0[r] = fadd_s(C0[r], ctn); C1[r] = fadd_s(C1[r], ctn); }     \
        const int jb_ = (t) - (NT - 4); if (jb_ >= 0) cmask(C0, C1, jb_, qrel, hi); } \
    } while (0)
    bool resc = false;
#define START(P0, P1) do { resc = false; \
    if (ONLINE) { const float rm = rowmax(P0, P1); const float dl = __builtin_fmaxf(rm, floorv); mhat = fadd_s(mhat, dl); \
      _Pragma("unroll") for (int r = 0; r < 16; ++r) { P0[r] = fsub_s(P0[r], dl); P1[r] = fsub_s(P1[r], dl); } \
      if (USE_NEGM) { _Pragma("unroll") for (int r = 0; r < 16; ++r) negm[r] = -mhat; asm volatile("" : "+v"(negm)); } } \
    _Pragma("unroll") for (int r = 0; r < 16; ++r) P0[r] = __builtin_amdgcn_exp2f(P0[r]); } while (0)
#define RESC() do { if (resc) { asm volatile("s_waitcnt lgkmcnt(0)" ::: "memory"); \
      _Pragma("unroll") for (int d_ = 0; d_ < 2; ++d_) _Pragma("unroll") for (int r = 0; r < 16; ++r) o[d_][r] *= wsf[crow(r, hi)]; } } while (0)
    f32x16 pA0, pA1, pB0, pB1;
    bool late_ = false; int tend2_ = 0;
    int sl_prev = 0, sl_cur = 0, sl_next = SLOTB;
#define ROT() do { sl_prev = sl_cur; sl_cur = sl_next; sl_next = (sl_next == (NSLOT - 1) * SLOTB) ? 0 : sl_next + SLOTB; } while (0)
    if (!RES && !P.pre) { DMA_K(2, 2 * SLOTB); DMA_V(1, SLOTB); }
    float floorv = -30.f, ctn = 0.f; (void)floorv;
    if (HOOK != HK_FOX) {
        if (P.tfill) {
            const int n = P.tlen, dbase = P.tCmax + 255 - P.toff;
            for (int j = tid; j < n; j += NW * 64) { f32x4 v;
#pragma unroll
                for (int k = 0; k < 4; ++k) { const int d = dbase - j - k; float x = -INFINITY; if (d >= 0 && d <= P.W) x = P.tg[d] - SM_REF; v[k] = x; }
                ((LAS f32x4*)tabL)[j] = v; }
            if (HOOK == HK_RELMASK && P.kmean) {
                LAS bf16* kmh_ = (LAS bf16*)kmL; LAS bf16* kml_ = kmh_ + 2048;
                for (int j = tid; j < 1024; j += NW * 64) { const int n_ = j >> 6, d_ = j & 63; const float v_ = P.kmean[j];
                    const unsigned hb_ = __float_as_uint(v_) >> 16; const float vh_ = __uint_as_float(hb_ << 16);
                    const unsigned lb_ = cvtpk_s(v_ - vh_, 0.f) & 0xffffu;
                    const int e_ = (d_ >> 3) * 256 + n_ * 8 + (d_ & 7);
                    kmh_[e_] = (bf16)hb_; kml_[e_] = (bf16)lb_; kmh_[e_ + 128] = 0; kml_[e_ + 128] = 0; } }
        }
    } else {
        if (P.tfill) {
            const f32x4 u0 = *(const f32x4*)(P.cseq + 8 * tid), u1 = *(const f32x4*)(P.cseq + 8 * tid + 4);
            float pf[8]; pf[0] = u0[0]; pf[1] = pf[0] + u0[1]; pf[2] = pf[1] + u0[2]; pf[3] = pf[2] + u0[3]; pf[4] = pf[3] + u1[0]; pf[5] = pf[4] + u1[1]; pf[6] = pf[5] + u1[2]; pf[7] = pf[6] + u1[3];
            float incl = pf[7];
#pragma unroll
            for (int o_ = 1; o_ < 64; o_ <<= 1) { const float up_ = __int_as_float(__builtin_amdgcn_ds_bpermute((lane - o_) << 2, __float_as_int(incl))); if (lane >= o_) incl += up_; }
            if (lane == 63) kmL[wid] = incl;
            asm volatile("s_waitcnt lgkmcnt(0)\n\ts_barrier" ::: "memory");
            float off_ = incl - pf[7];
#pragma unroll
            for (int w_ = 0; w_ < NW - 1; ++w_) off_ += (w_ < wid) ? kmL[w_] : 0.f;
#pragma unroll
            for (int i_ = 0; i_ < 8; ++i_) tabL[8 * tid + i_] = -(off_ + pf[i_]) * LOG2E;
        }
    }
    if (!P.pre) { mask = ~0ull; if (HOOK == HK_RELMASK && P.mask64) mask = P.mask64[P.q0 + qrel]; }
    if (USE_NEGM) { _Pragma("unroll") for (int r = 0; r < 16; ++r) negm[r] = ctn; asm volatile("" : "+v"(negm)); }
    int ta = 0;
    if (RES) {
        if (P.pre) asm volatile("s_waitcnt vmcnt(8) lgkmcnt(0)\n\ts_barrier" ::: "memory"); else asm volatile("s_waitcnt vmcnt(0) lgkmcnt(0)\n\ts_barrier" ::: "memory");
        const int tb_ = ((P.q0 + wid * QBLK + 31) >> 6) - P.t_lo; ta = tb_ - 2; ta = ta < 0 ? 0 : ta;
        if (P.nQp && P.ncont) {
            const int tend_ = (P.ntlo - P.t_lo) + P.nNT, te_ = tend_ < RSLOTS ? tend_ : RSLOTS;
            RES_DMA(NT, te_); }
    } else if (P.pre) { WAIT_BAR(8); }
    else
    WAIT_BAR(3);
    if (HOOK == HK_FOX) ctn = -tabL[P.q0 + qrel] - SM_REF;
    if (HOOK == HK_RELMASK && P.kmean) {
        const int qb = P.qb;
        f32x16 gs_; { const float z_ = opaque_zero(); _Pragma("unroll") for (int r = 0; r < 16; ++r) gs_[r] = z_; }
        { const LAS char* kb_ = (const LAS char*)kmL + hi * 512 + r32 * 16;
#pragma unroll
          for (int d0 = 0; d0 < 4; ++d0) { const bf16x8 ah_ = *(const LAS bf16x8*)(kb_ + d0 * 1024), al_ = *(const LAS bf16x8*)(kb_ + 4096 + d0 * 1024);
              gs_ = __builtin_amdgcn_mfma_f32_32x32x16_bf16(ah_, qr[d0], gs_, 0, 0, 0); gs_ = __builtin_amdgcn_mfma_f32_32x32x16_bf16(al_, qr[d0], gs_, 0, 0, 0); } }
        float sc_[16];
#pragma unroll
        for (int r = 0; r < 8; ++r) { auto rr = __builtin_amdgcn_permlane32_swap(__float_as_uint(gs_[r]), __float_as_uint(gs_[r]), false, false);
            const int n0_ = (r & 3) + 8 * (r >> 2); sc_[n0_] = __uint_as_float(rr[0]); sc_[n0_ + 4] = __uint_as_float(rr[1]); }
        float v1 = -INFINITY, v2 = -INFINITY, v3 = -INFINITY; int i1 = 31, i2 = 31, i3 = 31;
#pragma unroll
        for (int n = 0; n < 15; ++n) { if (n < qb) { const float s = sc_[n];
            if (s > v1) { v3 = v2; i3 = i2; v2 = v1; i2 = i1; v1 = s; i1 = n; } else if (s > v2) { v3 = v2; i3 = i2; v2 = s; i2 = n; } else if (s > v3) { v3 = s; i3 = n; } } }
        unsigned mk = (1u << qb) | ((1u << i1) | (1u << i2) | (1u << i3));
        mk &= 0xffffu;
        mask = (unsigned long long)mk;
    }
    BIASLD(pA0, pA1, ta); qkt_acc(pA0, pA1, Kbase + (RES ? RS(ta) : 0), qr, r32, hi); asm volatile("s_nop 15\n\ts_nop 7" : "+v"(pA0), "+v"(pA1)); POSTF(pA0, pA1, 0);
    START(pA0, pA1);
    _Pragma("unroll") for (int r = 0; r < 16; ++r) pA1[r] = __builtin_amdgcn_exp2f(pA1[r]);
    if (RES) { sl_prev = RS(ta); sl_cur = RS(ta + 1); sl_next = RS(ta + 2); kload8(kf, kp0 + sl_cur); asm volatile("s_waitcnt lgkmcnt(0)" ::: "memory"); }
    else {
    if (P.pre) { WAIT_BAR(8); } else
    WAIT_BAR(0);
    DMA_K(3, 0);
    ROT();
    kload8(kf, kp0 + sl_cur);
    WAIT_BAR(2);
    }
    s16x4 vlo[8], vhi[8]; u32x4 pw0, pw1, pw2, pw3;
#define PKW(P, B) cvtpk_s(P[B], P[B + 1])
#define PAF(k) __builtin_bit_cast(bf16x8, pw##k)
#define VFR(i) (bf16x8){vlo[i][0], vlo[i][1], vlo[i][2], vlo[i][3], vhi[i][0], vhi[i][1], vhi[i][2], vhi[i][3]}
#define PIN(x) asm volatile("" : "+v"(x))
#define MX3(a, b, c) __builtin_fmaxf(__builtin_fmaxf((a), (b)), (c))
#define GAPA(MF, A0, A1, A2, A3, W0, W1, PW) do { MF; sacc += A0; sacc += A1; sacc += A2; sacc += A3; PIN(sacc); W0; W1; PIN(PW); SBAR(); } while (0)
#define EX(v) __builtin_amdgcn_exp2f(v)
#define GAPB(MF, X, B) do { MF; PIN(o[0]); PIN(o[1]);     \
    X[B] = EX(X[B]); X[B + 1] = EX(X[B + 1]); X[B + 2] = EX(X[B + 2]); X[B + 3] = EX(X[B + 3]); PIN(X); SBAR(); } while (0)
#define VRD(i) do { vlo[i] = vtr(vp_ + (((i) >> 2) * 4096 + ((i) & 3) * 1024)); vhi[i] = vtr(vp_ + (((i) >> 2) * 4096 + ((i) & 3) * 1024 + 512)); } while (0)
#define KRD(G, j) do { if (G) { kload2(kf, kp0 + sl_next, j); SBAR(); } } while (0)
#define STEP(C0, C1, P0, P1, t, GK, GV, GL) do { SBAR(); \
    BIASLD(C0, C1, t); SBAR(); \
    const lds_cptr vp_ = vp0 + sl_prev; \
    VRD(0); SBAR(); float sacc = (P0[0] + P0[1]); \
    GAPA(C0 = __builtin_amdgcn_mfma_f32_32x32x16_bf16(kf[0], qr[0], C0, 0, 0, 0), P0[2], P0[3], P0[4], P0[5],     pw0[0] = PKW(P0, 0), pw0[1] = PKW(P0, 2), pw0); \
    VRD(4); SBAR(); GAPA(C1 = __builtin_amdgcn_mfma_f32_32x32x16_bf16(kf[1], qr[0], C1, 0, 0, 0), P0[6], P0[7], P0[8], P0[9],     pw0[2] = PKW(P0, 4), pw0[3] = PKW(P0, 6), pw0); \
    VRD(1); SBAR(); GAPA(C0 = __builtin_amdgcn_mfma_f32_32x32x16_bf16(kf[2], qr[1], C0, 0, 0, 0),   P0[10], P0[11], P0[12], P0[13], pw1[0] = PKW(P0, 8), pw1[1] = PKW(P0, 10), pw1); \
    VRD(5); SBAR(); GAPA(C1 = __builtin_amdgcn_mfma_f32_32x32x16_bf16(kf[3], qr[1], C1, 0, 0, 0),   P0[14], P0[15], P1[0], P1[1],   pw1[2] = PKW(P0, 12), pw1[3] = PKW(P0, 14), pw1); \
    VRD(2); SBAR(); GAPA(C0 = __builtin_amdgcn_mfma_f32_32x32x16_bf16(kf[4], qr[2], C0, 0, 0, 0),   P1[2], P1[3], P1[4], P1[5],     pw2[0] = PKW(P1, 0), pw2[1] = PKW(P1, 2), pw2); \
    VRD(6); SBAR(); GAPA(C1 = __builtin_amdgcn_mfma_f32_32x32x16_bf16(kf[5], qr[2], C1, 0, 0, 0),   P1[6], P1[7], P1[8], P1[9],     pw2[2] = PKW(P1, 4), pw2[3] = PKW(P1, 6), pw2); \
    VRD(3); SBAR(); GAPA(C0 = __builtin_amdgcn_mfma_f32_32x32x16_bf16(kf[6], qr[3], C0, 0, 0, 0),   P1[10], P1[11], P1[12], P1[13], pw3[0] = PKW(P1, 8), pw3[1] = PKW(P1, 10), pw3); \
    VRD(7); SBAR(); GAPA(C1 = __builtin_amdgcn_mfma_f32_32x32x16_bf16(kf[7], qr[3], C1, 0, 0, 0),   P1[14], P1[15], 0.f, 0.f,       pw3[2] = PKW(P1, 12), pw3[3] = PKW(P1, 14), pw3); \
    l_reg += sacc; \
    if (GK) { DMA_K((t) + 3, sl_cur); } if (GV) { DMA_V((t) + 1, sl_next); } \
    POSTF(C0, C1, t); \
    if (RES) { if (late_) {     \
        asm volatile("s_waitcnt lgkmcnt(0)\n\ts_barrier" ::: "memory"); RES_DMA(RSLOTS, tend2_); late_ = false; } } \
    if (ONLINE) { float a = MX3(C0[0], C0[1], C1[0]), b = MX3(C0[2], C0[3], C1[1]); a = MX3(a, C1[2], C1[3]); \
      _Pragma("unroll") for (int r = 4; r < 16; r += 4) { a = MX3(a, C0[r], C0[r + 1]); b = MX3(b, C0[r + 2], C0[r + 3]); a = MX3(a, C1[r], C1[r + 1]); b = MX3(b, C1[r + 2], C1[r + 3]); } \
      float rm = __builtin_fmaxf(a, b); { auto rr = __builtin_amdgcn_permlane32_swap(__float_as_uint(rm), __float_as_uint(rm), false, false); rm = __builtin_fmaxf(__uint_as_float(rr[0]), __uint_as_float(rr[1])); } \
      resc = false; \
      if (__builtin_expect(__any(rm > (float)THRL), 0)) { const float dl = __builtin_fmaxf(rm, 0.f); mhat += dl; \
        _Pragma("unroll") for (int r = 0; r < 16; ++r) { C0[r] -= dl; C1[r] -= dl; } \
        if (USE_NEGM) { _Pragma("unroll") for (int r = 0; r < 16; ++r) negm[r] = -mhat; asm volatile("" : "+v"(negm)); } \
        const float f = __builtin_amdgcn_exp2f(-dl); l_reg *= f; if (hi == 0) wsf[r32] = f; resc = true; } } \
    SBAR(); \
    GAPB(o[0] = __builtin_amdgcn_mfma_f32_32x32x16_bf16(PAF(0), VFR(0), o[0], 0, 0, 0), C0, 0); \
    GAPB(o[1] = __builtin_amdgcn_mfma_f32_32x32x16_bf16(PAF(0), VFR(4), o[1], 0, 0, 0), C0, 4); \
    KRD(GL, 0); GAPB(o[0] = __builtin_amdgcn_mfma_f32_32x32x16_bf16(PAF(1), VFR(1), o[0], 0, 0, 0), C0, 8); \
    KRD(GL, 1); GAPB(o[1] = __builtin_amdgcn_mfma_f32_32x32x16_bf16(PAF(1), VFR(5), o[1], 0, 0, 0), C0, 12); \
    KRD(GL, 2); GAPB(o[0] = __builtin_amdgcn_mfma_f32_32x32x16_bf16(PAF(2), VFR(2), o[0], 0, 0, 0), C1, 0); \
    KRD(GL, 3); GAPB(o[1] = __builtin_amdgcn_mfma_f32_32x32x16_bf16(PAF(2), VFR(6), o[1], 0, 0, 0), C1, 4); \
    GAPB(o[0] = __builtin_amdgcn_mfma_f32_32x32x16_bf16(PAF(3), VFR(3), o[0], 0, 0, 0), C1, 8); \
    GAPB(o[1] = __builtin_amdgcn_mfma_f32_32x32x16_bf16(PAF(3), VFR(7), o[1], 0, 0, 0), C1, 12); \
    } while (0)
#define DRAIN(X0, X1) do { float sacc = X0[0] + X0[1]; _Pragma("unroll") for (int r = 2; r < 16; ++r) sacc += X0[r]; _Pragma("unroll") for (int r = 0; r < 16; ++r) sacc += X1[r]; l_reg += sacc; \
      pw0 = (u32x4){PKW(X0, 0), PKW(X0, 2), PKW(X0, 4), PKW(X0, 6)}; pw1 = (u32x4){PKW(X0, 8), PKW(X0, 10), PKW(X0, 12), PKW(X0, 14)}; pw2 = (u32x4){PKW(X1, 0), PKW(X1, 2), PKW(X1, 4), PKW(X1, 6)}; pw3 = (u32x4){PKW(X1, 8), PKW(X1, 10), PKW(X1, 12), PKW(X1, 14)}; \
      SBAR(); pv(o, vb0 + sl_cur, PAF(0), PAF(1), PAF(2), PAF(3)); } while (0)
    if (RES) {
        STEP(pB0, pB1, pA0, pA1, ta + 1, false, false, true); asm volatile("s_waitcnt lgkmcnt(0)" ::: "memory");
        sl_prev = sl_cur; sl_cur = sl_next;
        { const int tend_ = (P.ntlo - P.t_lo) + P.nNT; if (P.nQp && P.ncont && tend_ > RSLOTS) { late_ = true; tend2_ = tend_; } }
        STEP(pA0, pA1, pB0, pB1, ta + 2, false, false, false);
        DRAIN(pA0, pA1);
    } else {
    const int NTw = (wid < 4) ? NT - 2 : NT;
    int t = 1;
    for (; t + 5 < NTw; t += 2) {
        STEP(pB0, pB1, pA0, pA1, t, true, true, true);     WAIT_BAR(2); RESC(); ROT();
        STEP(pA0, pA1, pB0, pB1, t + 1, true, true, true); WAIT_BAR(2); RESC(); ROT();
    }
#define ENDW(tt) do { if ((tt) + 3 < NT) { WAIT_BAR(2); } else if ((tt) + 2 < NT) { WAIT_BAR(1); } else { WAIT_BAR(0); } } while (0)
    for (; t + 1 < NTw; t += 2) {
        STEP(pB0, pB1, pA0, pA1, t, (t + 3 < NT), (t + 1 < NT), (t + 1 < NTw));       ENDW(t);     RESC(); ROT();
        STEP(pA0, pA1, pB0, pB1, t + 1, (t + 4 < NT), (t + 2 < NT), (t + 2 < NTw));   ENDW(t + 1); RESC(); ROT();
    }
    STEP(pB0, pB1, pA0, pA1, NTw - 1, false, (NTw < NT), false); RESC();
    if (NTw < NT) { ENDW(NTw - 1); }
    DRAIN(pB0, pB1);
    if (NTw < NT) { ROT(); DMA_V(NT - 1, sl_next); WAIT_BAR(0); }
    }
    float e_m1 = 0.f, e_l1 = 0.f, e_m2 = 0.f, e_l2 = 0.f; unsigned e_gate = 0u; u32x4 e_s1[4], e_s2[4];
    { const long qrow_ = P.q0 + qrel;
      if (P.ml1) { e_m1 = P.ml1[qrow_ * P.mls]; e_l1 = P.ml1[qrow_ * P.mls + 1]; e_m2 = P.ml2[qrow_ * P.mls]; e_l2 = P.ml2[qrow_ * P.mls + 1]; }
      else if (P.gate) e_gate = (unsigned)P.gate[qrow_ * P.grs];
      if (P.S1) {
#pragma unroll
          for (int i = 0; i < 4; ++i) { const long goff_ = ((long)(P.q0 + wid * QBLK) + i * 8 + (lane >> 3)) * P.ors + (lane & 7) * 8; e_s1[i] = *(const u32x4*)(P.S1 + goff_); if (P.S2) e_s2[i] = *(const u32x4*)(P.S2 + goff_); } } }
    if (P.nQp) {
        asm volatile("s_barrier" ::: "memory");
        const bf16* nk = P.img ? (P.nKp + (long)P.ntlo * 4096 + wid * 512 + lane * 8) : (P.nKp + ((long)P.ntlo * KVBLK + lane) * P.krs + wid * 8);
        const bf16* nv = P.img ? (P.nVp + (long)P.ntlo * 4096 + wid * 512 + lane * 8) : (P.nVp + ((long)P.ntlo * KVBLK + 16 * (wid & 3) + (lane >> 2)) * P.krs + (wid >> 2) * 32 + (lane & 3) * 8);
        if (RES) {
            if (!P.ncont) {
#pragma unroll 1
            for (int t_ = 0; t_ < P.nNT; ++t_) { const int ns_ = ((P.ntlo + t_) & (RSLOTS - 1)) * SLOTB; glds16(nk + t_ * tstride, (unsigned)__builtin_amdgcn_readfirstlane(kdst + ns_)); glds16(nv + t_ * tstride, (unsigned)__builtin_amdgcn_readfirstlane(vdst + ns_)); } }
        } else {
        glds16(nk, (unsigned)__builtin_amdgcn_readfirstlane(kdst)); glds16(nv, (unsigned)__builtin_amdgcn_readfirstlane(vdst));
        glds16(nk + tstride, (unsigned)__builtin_amdgcn_readfirstlane(kdst + SLOTB)); glds16(nk + 2 * tstride, (unsigned)__builtin_amdgcn_readfirstlane(kdst + 2 * SLOTB));
        glds16(nv + tstride, (unsigned)__builtin_amdgcn_readfirstlane(vdst + SLOTB));
        }
        const bf16* nQw = P.nQp + (long)(P.nq0 + wid * QBLK) * P.qrs;
#pragma unroll
        for (int d0 = 0; d0 < 4; ++d0) qr[d0] = *reinterpret_cast<const bf16x8*>(&nQw[(long)r32 * P.qrs + d0 * 16 + hi * 8]);
        if (HOOK == HK_RELMASK && P.mask64) mask = P.mask64[P.nq0 + qrel];
    }
#undef PKW
#undef PAF
#undef VFR
#undef PIN
#undef MX3
#undef GAPA
#undef GAPB
#undef EX
#undef VRD
#undef KRD
#undef STEP
#undef ENDW
#undef DRAIN
    { auto rr = __builtin_amdgcn_permlane32_swap(__float_as_uint(l_reg), __float_as_uint(l_reg), false, false); l_reg = __uint_as_float(rr[0]) + __uint_as_float(rr[1]); }
    {
        const long qrow = P.q0 + qrel;
        float sc, a1 = 0.f, a2 = 0.f;
        if (P.ml1) {
            const float m1 = e_m1, l1 = e_l1, m2 = e_m2, l2 = e_l2;
            const float Mx = fmaxf(fmaxf(m1, m2), mhat);
            const float e1 = __builtin_amdgcn_exp2f(m1 - Mx), e2 = __builtin_amdgcn_exp2f(m2 - Mx), e3 = __builtin_amdgcn_exp2f(mhat - Mx);
            const float w1 = l1 * e1, w2 = l2 * e2, w3 = l_reg * e3; const float iw = 1.0f / fmaxf((w1 + w2) + w3, 1e-30f);
            sc = e3 * iw; a1 = w1 * iw; a2 = w2 * iw;
        } else {
            sc = 1.0f / fmaxf(l_reg, 1e-30f);
            if (P.gate) { const float gl = bflo(e_gate); sc *= 1.0f / (1.0f + __expf(-gl)); }
            a1 = P.accum ? 1.f : 0.f;
        }
        if (P.ml_out && hi == 0) { P.ml_out[qrow * P.mls] = mhat; P.ml_out[qrow * P.mls + 1] = l_reg; }
        if (hi == 0) { wsf[32 + r32] = sc; wsf[64 + r32] = a1; wsf[96 + r32] = a2; }
    }
    asm volatile("s_waitcnt lgkmcnt(0)" ::: "memory");
    float rli[16];
#pragma unroll
    for (int r = 0; r < 16; ++r) rli[r] = wsf[32 + crow(r, hi)];
    {
        const int es_ = (P.nQp ? P.ntlo : P.t_lo) + 6;
        const unsigned sa_ = ((es_ & (RSLOTS - 1)) * SLOTB) + wid * 1024, sb_ = (((es_ + 1) & (RSLOTS - 1)) * SLOTB) + wid * 1024;
        const unsigned pc0_ = RES ? (LDS_K + sa_) : (L_OST + wid * 4096), pc1_ = RES ? (L_V + sa_) : (L_OST + wid * 4096 + 1024), pc2_ = RES ? (LDS_K + sb_) : (L_OST + wid * 4096 + 2048), pc3_ = RES ? (L_V + sb_) : (L_OST + wid * 4096 + 3072);
#define PCB(p) (LAS bf16*)((LAS char*)(uintptr_t)lds0 + ((p) == 0 ? pc0_ : ((p) == 1 ? pc1_ : ((p) == 2 ? pc2_ : pc3_))))
#pragma unroll
        for (int r = 0; r < 16; r += 1) { const int rowin = (r & 3) + 4 * hi; LAS bf16* pb_ = PCB(r >> 2);
#pragma unroll
            for (int d0 = 0; d0 < 2; ++d0) { const unsigned pk = cvtpk_s(o[d0][r] * rli[r], 0.f); pb_[rowin * 64 + d0 * 32 + r32] = (bf16)(pk & 0xffffu); } }
        asm volatile("s_waitcnt lgkmcnt(0)" ::: "memory");
        const long obase = (long)(P.q0 + wid * QBLK);
#pragma unroll
        for (int i = 0; i < 4; ++i) { const int row = i * 8 + (lane >> 3), ch = lane & 7; u32x4 v = *(const LAS u32x4*)(PCB(i) + (lane >> 3) * 64 + ch * 8);
            const long goff = (obase + row) * P.ors + ch * 8;
            if (P.S1) { const float c1 = wsf[64 + row]; const u32x4 s = e_s1[i];
                float f[8];
#pragma unroll
                for (int k = 0; k < 4; ++k) { f[2 * k] = bflo(v[k]) + c1 * bflo(s[k]); f[2 * k + 1] = bfhi(v[k]) + c1 * bfhi(s[k]); }
                if (P.S2) { const float c2 = wsf[96 + row]; const u32x4 s2 = e_s2[i];
#pragma unroll
                    for (int k = 0; k < 4; ++k) { f[2 * k] += c2 * bflo(s2[k]); f[2 * k + 1] += c2 * bfhi(s2[k]); } }
#pragma unroll
                for (int k = 0; k < 4; ++k) v[k] = cvtpk_s(f[2 * k], f[2 * k + 1]); }
            *(u32x4*)(P.Op + goff) = v; }
#undef PCB
    }
    if (!P.nQp) asm volatile("s_waitcnt lgkmcnt(0)\n\ts_barrier" ::: "memory");
#undef DMA_K
#undef DMA_V
#undef BIASLD
#undef POSTF
#undef CINIT
#undef START
#undef RESC
#undef RS
#undef RES_DMA
#undef ROT
}
#undef WAIT_BAR
}

typedef unsigned short bf16;
typedef unsigned v4u __attribute__((ext_vector_type(4)));
typedef float f32x4 __attribute__((ext_vector_type(4)));
#define LDS_WAIT() asm volatile("s_waitcnt lgkmcnt(0)" ::: "memory")
__device__ __forceinline__ unsigned f2bf(float f) { unsigned u = __builtin_bit_cast(unsigned, f); return (u + 0x7fffu + ((u >> 16) & 1u)) >> 16; }
__device__ __forceinline__ unsigned pk2(float lo, float hi) { return f2bf(lo) | (f2bf(hi) << 16); }
__device__ __forceinline__ float wave_sum(float v, int lane) {
#pragma unroll
    for (int o = 1; o < 64; o <<= 1) v += shx(v, o, lane);
    return v;
}
__device__ __forceinline__ int rel_bucket(int d) {
    if (d < 16) return d;
    const float v = logf((float)d / 16.0f) / 4.852030263919617f * 16.0f;
    const int b = 16 + (int)v; return b < 31 ? b : 31;
}
__device__ __forceinline__ int rel_bucket_fast(int d) {
    const float v = (__builtin_amdgcn_logf((float)d) - 4.0f) * (16.0f / 7.0f);
    int b = 16 + (int)v; b = b < 31 ? b : 31; return d < 16 ? d : b;
}
__device__ __forceinline__ void wt_load(const float* W, int ldw, int N, int nblk, int item, int lane, float (&wv)[32]) {
    const int kb = item / nblk, nb = item % nblk, k0 = 64 * kb, n0 = 32 * nb;
    const int nn = n0 + (lane & 31); const bool ok = nn < N;
#pragma unroll
    for (int i = 0; i < 32; ++i) { const int kk = 2 * i + (lane >> 5); wv[i] = ok ? W[(size_t)(k0 + kk) * ldw + nn] : 0.f; }
}
__device__ __forceinline__ void wt_store(int K, int nblk, bf16* WT, const float* gs, bool headperm, LAS float* scr, int item, int lane, const float (&wv)[32]) {
    const int kb = item / nblk, nb = item % nblk, k0 = 64 * kb, n0 = 32 * nb;
#pragma unroll
    for (int i = 0; i < 32; ++i) { const int kk = 2 * i + (lane >> 5); float v = wv[i]; if (gs) v *= gs[k0 + kk]; scr[kk * 33 + (lane & 31)] = v; }
    LDS_WAIT(); asm volatile("" ::: "memory");
    const int c = lane & 7;
    const int r0 = headperm ? (256 * (n0 / 256) + 128 * ((n0 % 64) / 32) + 32 * ((n0 % 256) / 64)) : n0;
#pragma unroll
    for (int j = 0; j < 4; ++j) { const int n = (lane >> 3) + 8 * j; const LAS float* s = scr + (8 * c) * 33 + n;
        v4u o; o.x = pk2(s[0 * 33], s[1 * 33]); o.y = pk2(s[2 * 33], s[3 * 33]); o.z = pk2(s[4 * 33], s[5 * 33]); o.w = pk2(s[6 * 33], s[7 * 33]);
        { const int row_ = r0 + n, kk_ = k0 + 8 * c; *(v4u*)(WT + ((size_t)((row_ >> 4) * (K / 32) + (kk_ >> 5)) * 512 + (row_ & 15) * 32 + (kk_ & 31))) = o; } }
    LDS_WAIT(); asm volatile("" ::: "memory");
}
__device__ __forceinline__ void wt_item(const float* W, int ldw, int N, int K, int nblk, bf16* WT, const float* gs, bool headperm, LAS float* scr, int item, int lane) {
    const int kb = item / nblk, nb = item % nblk, k0 = 64 * kb, n0 = 32 * nb;
    const int nn = n0 + (lane & 31); const bool ok = nn < N;
    float wv[32];
#pragma unroll
    for (int i = 0; i < 32; ++i) { const int kk = 2 * i + (lane >> 5); wv[i] = ok ? W[(size_t)(k0 + kk) * ldw + nn] : 0.f; }
#pragma unroll
    for (int i = 0; i < 32; ++i) { const int kk = 2 * i + (lane >> 5); float v = wv[i]; if (gs) v *= gs[k0 + kk]; scr[kk * 33 + (lane & 31)] = v; }
    LDS_WAIT(); asm volatile("" ::: "memory");
    const int c = lane & 7;
    const int r0 = headperm ? (256 * (n0 / 256) + 128 * ((n0 % 64) / 32) + 32 * ((n0 % 256) / 64)) : n0;
#pragma unroll
    for (int j = 0; j < 4; ++j) { const int n = (lane >> 3) + 8 * j; const LAS float* s = scr + (8 * c) * 33 + n;
        v4u o; o.x = pk2(s[0 * 33], s[1 * 33]); o.y = pk2(s[2 * 33], s[3 * 33]); o.z = pk2(s[4 * 33], s[5 * 33]); o.w = pk2(s[6 * 33], s[7 * 33]);
        { const int row_ = r0 + n, kk_ = k0 + 8 * c; *(v4u*)(WT + ((size_t)((row_ >> 4) * (K / 32) + (kk_ >> 5)) * 512 + (row_ & 15) * 32 + (kk_ & 31))) = o; } }
    LDS_WAIT(); asm volatile("" ::: "memory");
}


#define XB_TMO      128
#define XB_XCNT(j)  (256  + 64 * (j))
#define XB_XSUB(j)  (1280 + 64 * (j))
#define XB_XGEN(j)  (2304 + 64 * (j))
#define XB_TOP      3328
#define XB_TOPGEN   3392
#define XCD_BAR_WORDS 3456
#define XB_SPIN_CAP (1u << 18)

__device__ __forceinline__ unsigned xb_ld(unsigned* p)              { return __hip_atomic_load(p, __ATOMIC_RELAXED, __HIP_MEMORY_SCOPE_AGENT); }
__device__ __forceinline__ unsigned xb_add(unsigned* p, unsigned v) { return __hip_atomic_fetch_add(p, v, __ATOMIC_RELAXED, __HIP_MEMORY_SCOPE_AGENT); }
__device__ __forceinline__ unsigned xb_xcc_id() { return (unsigned)__builtin_amdgcn_s_getreg((3 << 11) | 20) & 0xFu; }
#define XB_SPIN(cond, bar) do { unsigned _sp = 0; while (cond) { __builtin_amdgcn_s_sleep(1); \
    if ((++_sp & 255u) == 0u) { if (xb_ld(&(bar)[XB_TMO])) break; if (_sp > XB_SPIN_CAP) { atomicAdd(&(bar)[XB_TMO], 1u); break; } } } } while (0)

struct XcdBarrier {
    unsigned* bar; unsigned x;
    volatile LAS unsigned* st;
};

__device__ __forceinline__ XcdBarrier xcd_barrier_post(unsigned* bar, volatile LAS unsigned* st, bool leader) {
    XcdBarrier b; b.bar = bar; b.x = xb_xcc_id(); b.st = st;
    if (leader) (void)xb_add(&bar[XB_XCNT(b.x)], 1u);
    return b;
}
__device__ __forceinline__ void xcd_barrier_complete(unsigned* bar, unsigned x, unsigned& nloc, unsigned& nx) {
    const unsigned G = gridDim.x * gridDim.y * gridDim.z;
    unsigned sum, cnt, mine, sp = 0u;
    for (;;) {
        sum = 0u; cnt = 0u; mine = 0u;
#pragma unroll
        for (unsigned j = 0; j < 16; ++j) { const unsigned c = xb_ld(&bar[XB_XCNT(j)]); sum += c; cnt += (c > 0u) ? 1u : 0u; mine = (j == x) ? c : mine; }
        if (sum == G) break;
        __builtin_amdgcn_s_sleep(1);
        if ((++sp & 255u) == 0u) { if (xb_ld(&bar[XB_TMO])) break; if (sp > XB_SPIN_CAP) { atomicAdd(&bar[XB_TMO], 1u); break; } }
    }
    nloc = mine > 0u ? mine : 1u; nx = cnt > 0u ? cnt : 1u;
}

__device__ __forceinline__ void xcd_barrier(const XcdBarrier& b, bool leader) {
    asm volatile("s_waitcnt vmcnt(0)" ::: "memory");
    __syncthreads();
    if (leader) {
        unsigned* bar = b.bar;
        __builtin_amdgcn_s_waitcnt(0);
        unsigned nloc = b.st[0], nx = b.st[1];
        if (nloc == 0u) { xcd_barrier_complete(bar, b.x, nloc, nx); b.st[0] = nloc; b.st[1] = nx; }
        const unsigned old = xb_add(&bar[XB_XSUB(b.x)], 1u);
        const unsigned gen = old / nloc;
        if (old + 1u == (gen + 1u) * nloc) {
            __builtin_amdgcn_fence(__ATOMIC_RELEASE, "agent");
            asm volatile("s_waitcnt vmcnt(0)" ::: "memory");
            const unsigned og = xb_add(&bar[XB_TOP], 1u);
            const unsigned tg = og / nx;
            if (og + 1u == (tg + 1u) * nx) xb_add(&bar[XB_TOPGEN], 1u);
            else XB_SPIN(xb_ld(&bar[XB_TOPGEN]) == tg, bar);
            __builtin_amdgcn_fence(__ATOMIC_ACQUIRE, "agent");
            xb_add(&bar[XB_XGEN(b.x)], 1u);
            asm volatile("s_waitcnt vmcnt(0)" ::: "memory");
        } else {
            XB_SPIN(xb_ld(&bar[XB_XGEN(b.x)]) == gen, bar);
            __builtin_amdgcn_fence(__ATOMIC_ACQUIRE, "agent");
            asm volatile("s_waitcnt vmcnt(0)" ::: "memory");
        }
    }
    __syncthreads();
}

namespace cmp {
using namespace att;
constexpr int L_K = 0, L_V = 32768, L_W = 65536, L_WSTRIDE = 32 * 65 * 4  , L_REL = L_W + 8 * L_WSTRIDE, L_SC = L_REL + 512, L_BT = L_SC + 8 * 128  , L_END = L_BT + 4096;
static_assert(L_END <= 140000, "cmp LDS map");
struct CmpP { const bf16* qkv; int pitch; const bf16* Kc; const bf16* Vc; const float* rel; bf16* O1; unsigned long long* sel; const bf16* gates; };
__device__ __forceinline__ void cmp_unit(const CmpP& P, int slab, int tb, char* shm, const int wave_s, const bool first) {
    int wid_l = wave_s; asm volatile("" : "+s"(wid_l));
    const int lane = lane_id_v(), wid = wid_l, tid = wid * 64 + lane, r32 = lane & 31, hi = lane >> 5;
    const int b = slab >> 2, kh = slab & 3, t0 = tb * 64;
    const int ntile = (4 * tb + 2) / 64 + 1;
    const unsigned lds0 = (unsigned)(uintptr_t)shm;
    LAS char* L = (LAS char*)(uintptr_t)lds0;
    const int tokl = r32 & 7, g = r32 >> 3, tok = t0 + 8 * wid + tokl, h = kh * 4 + g;
    const bf16* Qrow = P.qkv + (size_t)(b * SEQ + tok) * P.pitch + h * 64;
    bf16x8 qr[4];
#pragma unroll
    for (int d0 = 0; d0 < 4; ++d0) qr[d0] = *reinterpret_cast<const bf16x8*>(Qrow + d0 * 16 + hi * 8);
    const unsigned short gate_raw = P.gates[(size_t)(b * SEQ + tok) * 64 + h * 3 + 0];
    u32x4 sold[4];
#pragma unroll
    for (int i = 0; i < 4; ++i) { const int row = i * 8 + (lane >> 3), ch = lane & 7; sold[i] = *(const u32x4*)(P.O1 + (size_t)(b * SEQ + t0 + 8 * wid + (row & 7)) * DM + (kh * 4 + (row >> 3)) * 64 + ch * 8); }
    { const bf16* Kg = P.Kc + (size_t)slab * 256 * 64; const bf16* Vg = P.Vc + (size_t)slab * 256 * 64;
      u32x4 kst[4], vst[4];
      const int kc_ = tid >> 6, krow_ = tid & 63, vrow_ = 16 * ((tid >> 6) & 3) + ((tid & 63) >> 2), vcol_ = (tid >> 8) * 32 + (tid & 3) * 8;
#pragma unroll
      for (int tt = 0; tt < 4; ++tt) if (tt < ntile) { kst[tt] = *(const u32x4*)(Kg + (size_t)(tt * 64 + krow_) * 64 + kc_ * 8); vst[tt] = *(const u32x4*)(Vg + (size_t)(tt * 64 + vrow_) * 64 + vcol_); }
#pragma unroll
      for (int tt = 0; tt < 4; ++tt) if (tt < ntile) { *(LAS u32x4*)(L + L_K + tt * 8192 + kc_ * 1024 + krow_ * 16) = kst[tt]; *(LAS u32x4*)(L + L_V + tt * 8192 + (tid >> 6) * 1024 + (tid & 63) * 16) = vst[tt]; }
      if (tid < 128) { const int g = tid >> 5, bk = tid & 31; ((LAS float*)(L + L_REL))[tid] = P.rel[bk * 16 + kh * 4 + g] * LOG2E - SM_REF; } }
    if (first) { for (int d = tid; d < 4096; d += NW * 64) ((LAS unsigned char*)(L + L_BT))[d] = (unsigned char)rel_bucket_fast(d); }
    const LAS unsigned char* btL = (const LAS unsigned char*)(L + L_BT);
    LAS float* Wl = (LAS float*)(L + L_W + wid * L_WSTRIDE);
    for (int j = lane; j < 32 * 65; j += 64) Wl[j] = 0.f;
    asm volatile("s_waitcnt lgkmcnt(0)\n\ts_barrier" ::: "memory");
    const LAS float* relL = (const LAS float*)(L + L_REL) + g * 32;
    const float zf_ = opaque_zero(); f32x16 zero16; _Pragma("unroll") for (int r = 0; r < 16; ++r) zero16[r] = zf_; asm volatile("" : "+v"(zero16));
#define CBIAS(P0, P1, tt) do { const int dq_ = tok - 31 - 16 * (64 * (tt) + 4 * hi); \
    _Pragma("unroll") for (int r = 0; r < 16; ++r) { const int d0_ = dq_ - 16 * ((r & 3) + 8 * (r >> 2)), d1_ = d0_ - 512; \
        P0[r] = d0_ >= 0 ? P0[r] + relL[btL[d0_ < 0 ? 0 : d0_]] : -INFINITY; P1[r] = d1_ >= 0 ? P1[r] + relL[btL[d1_ < 0 ? 0 : d1_]] : -INFINITY; } } while (0)
    float l = 0.f;
    f32x16 o[2]; o[0] = zero16; o[1] = zero16;
    const int vb0 = (int)(lds0 + L_V) + ((lane >> 4) & 1) * 32 + (lane & 3) * 8 + (4 * hi + ((lane & 15) >> 2)) * 64;
    LAS float* Wrow = Wl + r32 * 65;
    for (int tt = 0; tt < ntile; ++tt) {
        f32x16 p0, p1; qkt(p0, p1, shm + L_K + tt * 8192, qr, zero16, r32, hi); CBIAS(p0, p1, tt);
        float s = 0.f;
#pragma unroll
        for (int r = 0; r < 16; ++r) { p0[r] = __builtin_amdgcn_exp2f(p0[r]); p1[r] = __builtin_amdgcn_exp2f(p1[r]); s += p0[r] + p1[r]; }
        l += s;
#pragma unroll
        for (int a = 0; a < 4; ++a) { const int j0 = 16 * tt + 2 * a + hi, j1 = j0 + 8;
            const float G0 = (p0[4 * a] + p0[4 * a + 1]) + (p0[4 * a + 2] + p0[4 * a + 3]), G1 = (p1[4 * a] + p1[4 * a + 1]) + (p1[4 * a + 2] + p1[4 * a + 3]);
            Wrow[j0] += G0; Wrow[j1] += G1; asm volatile("" ::: "memory");
            Wrow[j0 + 1] += p0[4 * a + 3]; Wrow[j1 + 1] += p1[4 * a + 3]; asm volatile("" ::: "memory"); }
        u32x4 pw0 = (u32x4){cvtpk_s(p0[0], p0[1]), cvtpk_s(p0[2], p0[3]), cvtpk_s(p0[4], p0[5]), cvtpk_s(p0[6], p0[7])};
        u32x4 pw1 = (u32x4){cvtpk_s(p0[8], p0[9]), cvtpk_s(p0[10], p0[11]), cvtpk_s(p0[12], p0[13]), cvtpk_s(p0[14], p0[15])};
        u32x4 pw2 = (u32x4){cvtpk_s(p1[0], p1[1]), cvtpk_s(p1[2], p1[3]), cvtpk_s(p1[4], p1[5]), cvtpk_s(p1[6], p1[7])};
        u32x4 pw3 = (u32x4){cvtpk_s(p1[8], p1[9]), cvtpk_s(p1[10], p1[11]), cvtpk_s(p1[12], p1[13]), cvtpk_s(p1[14], p1[15])};
        pv(o, vb0 + tt * 8192, __builtin_bit_cast(bf16x8, pw0), __builtin_bit_cast(bf16x8, pw1), __builtin_bit_cast(bf16x8, pw2), __builtin_bit_cast(bf16x8, pw3));
    }
#undef CBIAS
    { auto rr = __builtin_amdgcn_permlane32_swap(__float_as_uint(l), __float_as_uint(l), false, false); l = __uint_as_float(rr[0]) + __uint_as_float(rr[1]); }
    const float inv = l > 0.f ? 1.0f / l : 0.f;
    LAS float* scw = (LAS float*)(L + L_SC) + wid * 32;
    if (hi == 0) scw[r32] = inv;
    asm volatile("s_waitcnt lgkmcnt(0)" ::: "memory");
    { const int own = tb, j = lane;
      for (int tk = 0; tk < 8; ++tk) {
          float v = (Wl[(0 * 8 + tk) * 65 + j] * scw[0 * 8 + tk] + Wl[(1 * 8 + tk) * 65 + j] * scw[1 * 8 + tk]) + (Wl[(2 * 8 + tk) * 65 + j] * scw[2 * 8 + tk] + Wl[(3 * 8 + tk) * 65 + j] * scw[3 * 8 + tk]);
          const bool past = j < own; const float val = past ? v : -INFINITY;
          bool selb = (j <= own);
          if (own >= 16) {
              const unsigned bits = __float_as_uint(val); unsigned pre = 0u;
              for (int b = 30; b >= 0; --b) { const unsigned cand = pre | (1u << b); if (__popcll(__ballot(past && bits >= cand)) >= 15) pre = cand; }
              const int ngt = __popcll(__ballot(past && bits > pre));
              const unsigned long long tie = __ballot(past && bits == pre);
              const int rk = (int)__builtin_amdgcn_mbcnt_hi((unsigned)(tie >> 32), __builtin_amdgcn_mbcnt_lo((unsigned)tie, 0u));
              selb = (j == own) || (past && (bits > pre || (bits == pre && rk < 15 - ngt))); }
          const unsigned long long mk = __ballot(selb);
          if (lane == 0) P.sel[(size_t)slab * SEQ + t0 + 8 * wid + tk] = mk; } }
    asm volatile("s_waitcnt lgkmcnt(0)" ::: "memory");
    if (hi == 0) { const float gl = bflo((unsigned)gate_raw); scw[r32] = inv / (1.0f + __expf(-gl)); }
    asm volatile("s_waitcnt lgkmcnt(0)" ::: "memory");
    LAS bf16* stg = (LAS bf16*)Wl;
#pragma unroll
    for (int r = 0; r < 16; ++r) { const int orow = crow(r, hi); const float sc = scw[orow];
#pragma unroll
        for (int d0 = 0; d0 < 2; ++d0) { const unsigned pk = cvtpk_s(o[d0][r] * sc, 0.f); stg[orow * 64 + d0 * 32 + r32] = (bf16)(pk & 0xffffu); } }
    asm volatile("s_waitcnt lgkmcnt(0)" ::: "memory");
#pragma unroll
    for (int i = 0; i < 4; ++i) { const int row = i * 8 + (lane >> 3), ch = lane & 7; const u32x4 v = *(const LAS u32x4*)(stg + row * 64 + ch * 8);
        bf16* gp = P.O1 + (size_t)(b * SEQ + t0 + 8 * wid + (row & 7)) * DM + (kh * 4 + (row >> 3)) * 64 + ch * 8;
        const u32x4 s = sold[i]; u32x4 w;
#pragma unroll
        for (int k = 0; k < 4; ++k) w[k] = cvtpk_s(bflo(v[k]) + bflo(s[k]), bfhi(v[k]) + bfhi(s[k]));
        *(u32x4*)gp = w; }
    asm volatile("s_waitcnt lgkmcnt(0)\n\ts_barrier" ::: "memory");
}
}

constexpr size_t MiB = 1u << 20;
constexpr size_t WS_WIN = 0;
constexpr size_t WS_WOUT = 6 * MiB;
constexpr size_t WS_WUP = 8 * MiB;
constexpr size_t WS_WDN = 16 * MiB;
constexpr size_t WS_WC1 = 24 * MiB;
constexpr size_t WS_XB = 26 * MiB;
constexpr size_t WS_R = 58 * MiB;
constexpr size_t WS_O1 = WS_R + 96 * MiB;
constexpr size_t WS_RSSA = 186 * MiB;
constexpr size_t WS_RSSB = 187 * MiB;
constexpr size_t WS_TAB = 188 * MiB;
constexpr size_t WS_ML = 189 * MiB;
constexpr size_t WS_KC = 193 * MiB;
constexpr size_t WS_VC = 201 * MiB;
constexpr size_t WS_HID = 210 * MiB;
constexpr size_t WS_KCMP = 214 * MiB;
constexpr size_t WS_VCMP = 215 * MiB;
constexpr size_t WS_SEL = 216 * MiB;
constexpr size_t WS_FLOG = 217 * MiB;
constexpr size_t WS_KMEAN = 218 * MiB;
constexpr size_t WS_POSB = 219 * MiB;
constexpr size_t WS_BAR = 219 * MiB + 524288;
constexpr size_t WS_END = 220 * MiB;
constexpr int LDS_BYTES = 147456;
constexpr int LDS_RSTD = 131072;
constexpr int LDS_MISC = LDS_BYTES - 64;

struct Args { const float* in[17]; float* out; unsigned char* ws; };

__device__ __forceinline__ void x_to_bf16_rss(const float* x, bf16* xb, float* rss, int gw, int NGW, int lane) {
    for (int m = gw; m < MTOK; m += NGW) {
        const f32x4* xr = (const f32x4*)(x + (size_t)m * DM) + lane; f32x4 v[4]; float s = 0.f;
#pragma unroll
        for (int j = 0; j < 4; ++j) { v[j] = xr[64 * j]; s += (v[j][0] * v[j][0] + v[j][1] * v[j][1]) + (v[j][2] * v[j][2] + v[j][3] * v[j][3]); }
        s = wave_sum(s, lane);
        unsigned long long* o8 = (unsigned long long*)(xb + (size_t)(m >> 4) * (DM / 32) * 512 + (lane >> 3) * 512 + (m & 15) * 32 + 4 * (lane & 7));
#pragma unroll
        for (int j = 0; j < 4; ++j) o8[(8 * j) * 128] = (unsigned long long)pk2(v[j][0], v[j][1]) | ((unsigned long long)pk2(v[j][2], v[j][3]) << 32);
        if (lane < 16) rss[(size_t)m * 16 + lane] = (lane == 0) ? s : 0.f;
    }
}
__device__ __forceinline__ void fox_logf(const bf16* x, const float* rss, const float* g, const float* wfox, const float* bf, float* flog, LAS float* wg, int tid, int gw, int NGW, int lane) {
    for (int i = tid; i < 1024 * 16; i += 512) { const int k = i >> 4, h = i & 15; wg[h * 1024 + k] = g[k] * wfox[(size_t)k * FOX_LDW + 3072 + h]; }
    __syncthreads();
    for (int m = gw; m < MTOK; m += NGW) {
        const unsigned long long* xr = (const unsigned long long*)(x + (size_t)(m >> 4) * (DM / 32) * 512 + (lane >> 3) * 512 + (m & 15) * 32 + 4 * (lane & 7)); float acc[16];
#pragma unroll
        for (int h = 0; h < 16; ++h) acc[h] = 0.f;
        f32x4 xv[4];
#pragma unroll
        for (int j = 0; j < 4; ++j) { const unsigned long long w = xr[(8 * j) * 128]; const unsigned lo = (unsigned)w, hi2 = (unsigned)(w >> 32);
            xv[j] = (f32x4){__uint_as_float(lo << 16), __uint_as_float(lo & 0xffff0000u), __uint_as_float(hi2 << 16), __uint_as_float(hi2 & 0xffff0000u)}; }
#pragma unroll 1
        for (int j = 0; j < 4; ++j) { const f32x4 v = (j == 0) ? xv[0] : ((j == 1) ? xv[1] : ((j == 2) ? xv[2] : xv[3]));
#pragma unroll
            for (int h = 0; h < 16; ++h) { const f32x4 w = *(const LAS f32x4*)(wg + h * 1024 + 256 * j + 4 * lane); acc[h] += (v[0] * w[0] + v[1] * w[1]) + (v[2] * w[2] + v[3] * w[3]); } }
        float mine = 0.f;
#pragma unroll
        for (int h = 0; h < 16; ++h) { const float s = wave_sum(acc[h], lane); if (lane == h) mine = s; }
        if (lane < 16) {
            const float rstd = pg8::row_rstd(rss, m);
            const float z = mine * rstd + bf[lane];
            const float e = __expf(-fabsf(z)); const float l1p = (e < 0.03125f) ? e * (1.0f - e * (0.5f - e * (1.0f / 3.0f))) : __logf(1.0f + e);
            const float lf = fminf(z, 0.f) - l1p;
            const int b = m / SEQ, t = m % SEQ; flog[(size_t)(b * 16 + lane) * SEQ + t] = lf;
        }
    }
}
__device__ __forceinline__ void fox_logf_mfma(const bf16* x, const float* rss, const float* g, const float* wfox, const float* bf, float* flog, LAS unsigned char* L, int tid, int gw, int lane) {
    typedef __attribute__((ext_vector_type(8))) short bf16x8_t; typedef float f32x4_t __attribute__((ext_vector_type(4)));
    constexpr int WST = 1024 + 8;
    LAS bf16* whi = (LAS bf16*)L; LAS bf16* wlo = whi + 16 * WST;
    for (int i = tid; i < 1024 * 16; i += 512) { const int k = i >> 4, h = i & 15; const float v = g[k] * wfox[(size_t)k * FOX_LDW + 3072 + h];
        const unsigned hb = f2bf(v); const float vh = __uint_as_float(hb << 16); whi[h * WST + k] = (bf16)hb; wlo[h * WST + k] = (bf16)f2bf(v - vh); }
    __syncthreads();
    if ((gw & 7) < 4) {
        const int grp = (gw >> 3) * 4 + (gw & 7);
        const int r = lane & 15, kg = lane >> 4;
        const bf16* xg = x + (size_t)grp * (DM / 32) * 512 + r * 32 + kg * 8;
        const float zq_ = opaque_zero(); f32x4_t acc = {zq_, zq_, zq_, zq_};
#pragma unroll 1
        for (int half = 0; half < 2; ++half) {
            bf16x8_t xf[16];
#pragma unroll
            for (int j = 0; j < 16; ++j) xf[j] = *(const bf16x8_t*)(xg + (size_t)(half * 16 + j) * 512);
#pragma unroll
            for (int j = 0; j < 16; ++j) { const int k0 = (half * 16 + j) * 32 + kg * 8;
                const bf16x8_t a_hi = *(const LAS bf16x8_t*)(whi + r * WST + k0), a_lo = *(const LAS bf16x8_t*)(wlo + r * WST + k0);
                acc = __builtin_amdgcn_mfma_f32_16x16x32_bf16(a_hi, xf[j], acc, 0, 0, 0);
                acc = __builtin_amdgcn_mfma_f32_16x16x32_bf16(a_lo, xf[j], acc, 0, 0, 0); }
        }
        const int m = grp * 16 + r;
        const float rstd = pg8::row_rstd(rss, m);
        const int b = m / SEQ, t = m % SEQ;
#pragma unroll
        for (int i = 0; i < 4; ++i) { const int h = 4 * kg + i;
            const float z = acc[i] * rstd + bf[h];
            const float e = __expf(-fabsf(z)); const float l1p = (e < 0.03125f) ? e * (1.0f - e * (0.5f - e * (1.0f / 3.0f))) : __logf(1.0f + e);
            flog[(size_t)(b * 16 + h) * SEQ + t] = fminf(z, 0.f) - l1p; }
    }
}
__device__ __forceinline__ void scan4096(float* p, int lane) {
    f32x4* q = (f32x4*)(p + lane * 64); float tot = 0.f;
    for (int i = 0; i < 16; ++i) { const f32x4 v = q[i]; tot += (v[0] + v[1]) + (v[2] + v[3]); }
    float incl = tot;
#pragma unroll
    for (int o = 1; o < 64; o <<= 1) { const float up = __int_as_float(__builtin_amdgcn_ds_bpermute((lane - o) << 2, __float_as_int(incl))); if (lane >= o) incl += up; }
    float run = incl - tot;
    for (int i = 0; i < 16; ++i) { f32x4 v = q[i]; v[0] += run; v[1] += v[0]; v[2] += v[1]; v[3] += v[2]; run = v[3]; q[i] = v; }
}
__device__ __forceinline__ void cmp2_rows(const bf16* hid, const float* w2  , const float* kg, bf16* Kcmp, bf16* Vcmp, LAS float* w2L, int tid, int gw, int NGW, int lane) {
    const int br = (gw * 2 >= NGW) ? 1 : 0, gwb = gw - br * (NGW / 2);
    { float t_[32];
#pragma unroll
      for (int i = 0; i < 32; ++i) t_[i] = w2[br * 256 * 64 + tid + 512 * i];
#pragma unroll
      for (int i = 0; i < 32; ++i) w2L[br * 256 * 64 + tid + 512 * i] = t_[i]; }
    __syncthreads();
    for (int row = gwb; row < 4096; row += NGW / 2) {
        const int r = br * 4096 + row;
        const unsigned long long hv = *((const unsigned long long*)(hid + (size_t)r * 256) + lane);
        const unsigned lo = (unsigned)hv, hi2 = (unsigned)(hv >> 32);
        const float h0 = __uint_as_float(lo << 16), h1 = __uint_as_float(lo & 0xffff0000u), h2 = __uint_as_float(hi2 << 16), h3 = __uint_as_float(hi2 & 0xffff0000u);
        const LAS float* wl = w2L + br * 256 * 64 + lane; float acc = 0.f;
        for (int jl = 0; jl < 64; ++jl) {
            const float a0 = __uint_as_float(__builtin_amdgcn_readlane(__float_as_uint(h0), jl)), a1 = __uint_as_float(__builtin_amdgcn_readlane(__float_as_uint(h1), jl));
            const float a2 = __uint_as_float(__builtin_amdgcn_readlane(__float_as_uint(h2), jl)), a3 = __uint_as_float(__builtin_amdgcn_readlane(__float_as_uint(h3), jl));
            acc += a0 * wl[(4 * jl) * 64]; acc += a1 * wl[(4 * jl + 1) * 64]; acc += a2 * wl[(4 * jl + 2) * 64]; acc += a3 * wl[(4 * jl + 3) * 64]; }
        if (br == 0) { const float ss = wave_sum(acc * acc, lane); acc = acc * rsqrtf(ss * (1.0f / 64.0f) + RMS_EPS) * kg[lane]; Kcmp[(size_t)row * 64 + lane] = (bf16)f2bf(acc); }
        else Vcmp[(size_t)row * 64 + lane] = (bf16)f2bf(acc);
    }
}

__device__ __forceinline__ void cmp2_mfma(const bf16* hid, const float* w2  , const float* kg_, bf16* Kcmp, bf16* Vcmp, LAS unsigned char* L, int tid, int wave, int lane, int br, int rowbase) {
    typedef __attribute__((ext_vector_type(8))) short bf16x8_t; typedef float f32x4_t __attribute__((ext_vector_type(4)));
    constexpr int WST = 256 + 8;
    LAS bf16* whi = (LAS bf16*)L; LAS bf16* wlo = whi + 64 * WST;
    for (int i = tid; i < 256 * 64; i += 512) { const int k = i >> 6, o = i & 63; const float v = w2[br * 256 * 64 + i];
        const unsigned hb = f2bf(v); const float vh = __uint_as_float(hb << 16); whi[o * WST + k] = (bf16)hb; wlo[o * WST + k] = (bf16)f2bf(v - vh); }
    __syncthreads();
#pragma unroll 1
    for (int gq = 0; gq < 2; ++gq) {
        const int row0 = rowbase + (wave * 2 + gq) * 16;
        const int r = lane & 15, kq = lane >> 4;
        const bf16* hp = hid + (size_t)(br * 4096 + row0 + r) * 256 + kq * 8;
        bf16x8_t xf[8];
#pragma unroll
        for (int j = 0; j < 8; ++j) xf[j] = *(const bf16x8_t*)(hp + j * 32);
        f32x4_t acc[4]; const float zq_ = opaque_zero();
#pragma unroll
        for (int ot = 0; ot < 4; ++ot) { acc[ot] = (f32x4_t){zq_, zq_, zq_, zq_};
#pragma unroll
            for (int j = 0; j < 8; ++j) { const int k0 = j * 32 + kq * 8;
                const bf16x8_t a_hi = *(const LAS bf16x8_t*)(whi + (ot * 16 + r) * WST + k0), a_lo = *(const LAS bf16x8_t*)(wlo + (ot * 16 + r) * WST + k0);
                acc[ot] = __builtin_amdgcn_mfma_f32_16x16x32_bf16(a_hi, xf[j], acc[ot], 0, 0, 0);
                acc[ot] = __builtin_amdgcn_mfma_f32_16x16x32_bf16(a_lo, xf[j], acc[ot], 0, 0, 0); } }
        float sc = 1.f;
        if (br == 0) { float ss = 0.f;
#pragma unroll
            for (int ot = 0; ot < 4; ++ot) ss += (acc[ot][0] * acc[ot][0] + acc[ot][1] * acc[ot][1]) + (acc[ot][2] * acc[ot][2] + acc[ot][3] * acc[ot][3]);
            ss += shx(ss, 16, lane); ss += shx(ss, 32, lane);
            sc = rsqrtf(ss * (1.0f / 64.0f) + RMS_EPS); }
        bf16* op = (br == 0 ? Kcmp : Vcmp) + (size_t)(row0 + r) * 64 + 4 * kq;
#pragma unroll
        for (int ot = 0; ot < 4; ++ot) { float v[4];
#pragma unroll
            for (int i = 0; i < 4; ++i) v[i] = (br == 0) ? acc[ot][i] * sc * kg_[ot * 16 + 4 * kq + i] : acc[ot][i];
            *(unsigned long long*)(op + ot * 16) = (unsigned long long)pk2(v[0], v[1]) | ((unsigned long long)pk2(v[2], v[3]) << 32); }
    }
}

#define WJ_DECL(id, PE, PW, PL, PN, PK, PNP, PWT, PG, PH) const float* wjW_##id = (PW); const int wjl_##id = (PL), wjn_##id = (PN), wjk_##id = (PK), wjb_##id = (PNP) / 32, wjc_##id = (PE) ? ((PK) / 64) * wjb_##id : 0; \
    bf16* wjT_##id = (PWT); const float* wjg_##id = (PG); const bool wjh_##id = (PH); const int wjr_##id = (gw - jbase % NGW + NGW) % NGW; const bool wjx_##id = wjr_##id < wjc_##id; const int wji_##id = wjx_##id ? wjr_##id : 0; jbase += wjc_##id; float wjv_##id[32]
#define WJ_LOAD(id) wt_load(wjW_##id, wjl_##id, wjn_##id, wjb_##id, wji_##id, lane, wjv_##id)
#define WJ_STORE(id) do { if (wjx_##id) wt_store(wjk_##id, wjb_##id, wjT_##id, wjg_##id, wjh_##id, scrw, wji_##id, lane, wjv_##id); } while (0)

__device__ __forceinline__ void wjob(const float* W, int ldw, int N, int K, int Npad, bf16* WT, const float* gs, bool headperm, int& base, LAS float* scr, int gw, int NGW, int lane) {
    const int nblk = Npad / 32, nit = (K / 64) * nblk;
    const int first = (gw - base % NGW + NGW) % NGW;
    for (int it = first; it < nit; it += NGW) wt_item(W, ldw, N, K, nblk, WT, gs, headperm, scr, it, lane);
    base += nit;
}
__global__ void __launch_bounds__(512, 2) fwd_mega(Args args) {
    extern __shared__ __attribute__((aligned(16))) unsigned char lds[];
    cg::grid_group grid = cg::this_grid();
    constexpr int G = 256; const int bx = blockIdx.x;
    const int wave_s = __builtin_amdgcn_readfirstlane((int)threadIdx.x >> 6);
    const int vcu_top = (G % 8 == 0) ? (bx % 8) * (G / 8) + bx / 8 : bx; const int vcu = vcu_top;
    const int NGW = G * 8;
    LAS unsigned char* ldsL = (LAS unsigned char*)lds;
    unsigned char* const ws_top = args.ws; unsigned char* const ws = ws_top;
    float* const xres = args.out;
#define x_in args.in[0]
#define rel args.in[1]
#define attn_norm args.in[2]
#define mlp_norm args.in[3]
#define q_gain args.in[4]
#define k_gain args.in[5]
#define w_out args.in[6]
#define w_up args.in[7]
#define w_dn args.in[8]
#define cmp_pos args.in[11]
#define cmp_w1 args.in[12]
#define cmp_w2 args.in[13]
#define fox_bf args.in[15]
#define Win ((bf16*)(ws + WS_WIN))
#define Wout ((bf16*)(ws + WS_WOUT))
#define Wup ((bf16*)(ws + WS_WUP))
#define Wdn ((bf16*)(ws + WS_WDN))
#define Wc1 ((bf16*)(ws + WS_WC1))
#define XB ((bf16*)(ws + WS_XB))
#define QKV ((bf16*)(ws + WS_R))
#define QB QKV
#define KI ((bf16*)(ws + WS_R + 32 * MiB))
#define VI ((bf16*)(ws + WS_R + 64 * MiB))
#define KSI ((bf16*)(ws + WS_R + 32 * MiB))
#define VSI ((bf16*)(ws + WS_R + 40 * MiB))
#define KWI ((bf16*)(ws + WS_R + 48 * MiB))
#define VWI ((bf16*)(ws + WS_R + 56 * MiB))
#define GATES ((bf16*)(ws + WS_R + 64 * MiB))
#define O1 ((bf16*)(ws + WS_O1))
#define O2 XB
#define HB ((bf16*)(ws + WS_R))
#define rssA ((float*)(ws + WS_RSSA))
#define rssB ((float*)(ws + WS_RSSB))
#define TAB ((float*)(ws + WS_TAB))
#define ML ((float*)(ws + WS_ML))
#define KC ((bf16*)(ws + WS_KC))
#define VC ((bf16*)(ws + WS_VC))
#define HID ((bf16*)(ws + WS_HID))
#define KCMP ((bf16*)(ws + WS_KCMP))
#define VCMP ((bf16*)(ws + WS_VCMP))
#define SEL ((unsigned long long*)(ws + WS_SEL))
#define FLOG ((float*)(ws + WS_FLOG))
#define KMEAN ((float*)(ws + WS_KMEAN))
#define POSB ((float*)(ws + WS_POSB))
#define POSBP ((float*)(ws + WS_POSB + 4096))
#define PHASE_TID int wave_l_ = wave_s; asm volatile("" : "+s"(wave_l_)); const int lane = lane_id_v(), wave = wave_l_, tid = wave * 64 + lane, gw = vcu * 8 + wave; LAS float* scrw = (LAS float*)(ldsL + wave * 16384); (void)tid; (void)lane; (void)gw; (void)scrw
#define W_IN_PTR(L) ((L) == 0 ? args.in[9] : ((L) == 1 ? args.in[10] : ((L) == 2 ? args.in[14] : args.in[16])))
#define JOB_IN(L) wjob(W_IN_PTR(L), (L) == 1 ? NSA_N : ((L) == 2 ? FOX_LDW : 3072), (L) == 1 ? NSA_N : 3072, 1024, (L) == 1 ? NSA_NP : 3072, Win, attn_norm + (L) * DM, true, jbase, scrw, gw, NGW, lane)
#define JOB_OUT(L) wjob(w_out + (size_t)(L) * DM * DM, DM, DM, DM, DM, Wout, nullptr, false, jbase, scrw, gw, NGW, lane)
#define JOB_UP(L) wjob(w_up + (size_t)(L) * DM * FF, FF, FF, DM, FF, Wup, mlp_norm + (L) * DM, false, jbase, scrw, gw, NGW, lane)
#define JOB_DN(L) wjob(w_dn + (size_t)(L) * FF * DM, DM, DM, FF, DM, Wdn, nullptr, false, jbase, scrw, gw, NGW, lane)

    volatile LAS unsigned* misc = (volatile LAS unsigned*)(ldsL + LDS_MISC);
    { const int l0 = lane_id_v(); if (wave_s == 0 && l0 < 16) misc[l0] = 0u; }
    __syncthreads();
    XcdBarrier xbar = xcd_barrier_post((unsigned*)(ws + WS_BAR), misc, (wave_s == 0 && lane_id_v() == 0));
#define XBAR() xcd_barrier(xbar, (wave_s == 0 && lane_id_v() == 0))
    grid.sync();

    for (int ph = -1; ph < 32; ++ph) {
      { const int L = ph >> 3, st = ph < 0 ? 99 : (ph & 7);
        int vcu = vcu_top; asm volatile("" : "+s"(vcu));
        unsigned char* ws = ws_top; asm volatile("" : "+s"(ws));
        bool did = false;
        if (ph < 0) {
        PHASE_TID;
        int jbase = 0;
        WJ_DECL(pi, true, W_IN_PTR(0), 3072, 3072, 1024, 3072, Win, attn_norm, true);
        WJ_DECL(pa, true, cmp_w1, 256, 256, 2048, 256, Wc1, (const float*)nullptr, false);
        WJ_DECL(pb, true, cmp_w1 + 2048 * 256, 256, 256, 2048, 256, Wc1 + 256 * 2048, (const float*)nullptr, false);
        WJ_LOAD(pi); WJ_LOAD(pa); WJ_STORE(pi); WJ_LOAD(pb); WJ_STORE(pa); WJ_STORE(pb);
        x_to_bf16_rss(x_in, XB, rssA, gw, NGW, lane);
        const int gt = vcu * 512 + tid, NGT = G * 512;
        for (int i = gt; i < 3 * 16 * 4096; i += NGT) { const int p = i / 65536, h = (i >> 12) & 15, d = i & 4095; const int dil = (p == 0) ? 1 : (p == 1 ? 4 : 16);
            TAB[i] = rel[rel_bucket(d * dil) * 16 + h] * LOG2E; }
        for (int i = gt; i < 64 * 16 * 64; i += NGT) KMEAN[i] = 0.f;
        if ((gw & 7) == 7) { const int id_ = gw >> 3; const int br = id_ >> 7, cg = (id_ >> 5) & 3, kr = id_ & 31, c = cg * 64 + lane; const float* pp = cmp_pos + br * 2048 + kr * 64; const float* ww = cmp_w1 + ((size_t)br * 2048 + kr * 64) * 256 + c; float s = 0.f;
#pragma unroll
            for (int k = 0; k < 64; ++k) s += pp[k] * ww[(size_t)k * 256];
            POSBP[(br * 32 + kr) * 256 + c] = s; }
        did = true; }

        if (st == 0) {
            const int Np = (L == 1) ? NSA_NP : 3072;
            pg8::Gemm g{XB, Win, MTOK, Np, DM, DM, 1}; pg8::StaticOrder S; S.init(MTOK, Np, G, bx);
            unsigned long long modes;
            if (L == 1) modes = 0x55ull | (3ull << 8) | (3ull << 10) | (2ull << 12) | (0ull << 14) | (2ull << 16) | (0ull << 18) | (0ull << 20);
            else modes = 0x55ull | (0xAAull << 8);
            auto pre = [&](int tid) __attribute__((always_inline)) { if (tid < 128) ((LAS float*)(ldsL + LDS_RSTD + 4096))[tid] = (tid < 64) ? q_gain[L * HD + tid] : k_gain[L * HD + tid - 64]; pg8::rstd_prepass(S, rssA, (LAS float*)(ldsL + LDS_RSTD), tid); };
            unsigned long long dk = 0ull, isel = 0ull, ih0 = 0ull;
            if (L == 1) { dk = (1ull << 18) | (2ull << 21) | (1ull << 24) | (2ull << 27) | (4ull << 30); isel = (1ull << 21) | (2ull << 24) | (3ull << 27); ih0 = (6ull << 24) | (7ull << 28) | (8ull << 32) | (9ull << 36); }
            else if (L >= 2) { dk = (1ull << 12) | (1ull << 15) | (1ull << 18) | (1ull << 21) | (2ull << 24) | (2ull << 27) | (2ull << 30) | (2ull << 33); isel = (1ull << 24) | (1ull << 27) | (1ull << 30) | (1ull << 33);
                ih0 = (4ull << 16) | (4ull << 20) | (4ull << 24) | (4ull << 28) | (8ull << 32) | (8ull << 36) | (8ull << 40) | (8ull << 44); }
            pg8::EpiIn E{QKV, L == 0 ? 3072 : 1024, (const LAS float*)(ldsL + LDS_RSTD), (const LAS float*)(ldsL + LDS_RSTD + 4096), (const LAS float*)(ldsL + LDS_RSTD + 4096 + 256), modes, KC, VC, 4, (L == 3) ? KMEAN : nullptr,
                         dk, isel, ih0, L == 1 ? 4 : 16, L == 1 ? KSI : KI, L == 1 ? VSI : VI, KWI, VWI, GATES};
            pg8::gemm_phase<pg8::EpiIn, pg8::StaticOrder, true, true>(ldsL, g, S, E, wave_s, pre);
            if (L == 2) { PHASE_TID; __syncthreads(); fox_logf_mfma(XB, rssA, attn_norm + 2 * DM, args.in[14], fox_bf, FLOG, ldsL, tid, gw, lane); }
            did = true;
        }
        if (st == 1) {
            PHASE_TID; int jbase = 0;
            WJ_DECL(o, true, w_out + (size_t)L * DM * DM, DM, DM, DM, DM, Wout, (const float*)nullptr, false);
            WJ_DECL(u, true, w_up + (size_t)L * DM * FF, FF, FF, DM, FF, Wup, mlp_norm + L * DM, false);
            WJ_DECL(d, true, w_dn + (size_t)L * FF * DM, DM, DM, FF, DM, Wdn, (const float*)nullptr, false);
            const int Ln = L <= 2 ? L + 1 : 3;
            WJ_DECL(i, L <= 2, W_IN_PTR(Ln), Ln == 1 ? NSA_N : (Ln == 2 ? FOX_LDW : 3072), Ln == 1 ? NSA_N : 3072, 1024, Ln == 1 ? NSA_NP : 3072, Win, attn_norm + Ln * DM, true);
            WJ_LOAD(o); WJ_LOAD(u); WJ_STORE(o); WJ_LOAD(d); WJ_STORE(u); WJ_LOAD(i); WJ_STORE(d); WJ_STORE(i);
            if (L == 0 && vcu == 0) { const int br = tid >> 8, c = tid & 255; float s = 0.f; for (int kr = 0; kr < 32; ++kr) s += POSBP[(br * 32 + kr) * 256 + c]; POSB[tid] = s; }
            __syncthreads();
            did = true;
        }
        if (L == 1 && st == 1) {
            {
                const int br = (bx >> 4) & 1;
                pg8::Gemm g{br == 0 ? KC : VC, Wc1 + (size_t)br * 256 * 2048, 4096, 256, 2048, 1024}; pg8::StaticOrder S; S.init(4096, 256, G, bx < 32 ? (bx & 15) : 100000);
                pg8::EpiCmp E{HID + (size_t)br * 4096 * 256, POSB + br * 256};
                pg8::gemm_phase<pg8::EpiCmp, pg8::StaticOrder, true, true>(ldsL, g, S, E, wave_s);
                __syncthreads();
                if (bx < 32) {
                    PHASE_TID; pg8::Unit u0; S.next(0, u0);
                    cmp2_mfma(HID, cmp_w2, k_gain + 1 * HD, KCMP, VCMP, ldsL, tid, wave, lane, br, u0.pm * 256);
                    __syncthreads(); }
            }
        }
        {
            const int relv = (L == 0 && st == 1) ? 0 : ((L == 0 && st == 2) ? 1 : ((L == 1 && st == 1) ? 2 : -1));
            if (relv >= 0) {
                const int vq = vcu & 31;
                const int ni = relv == 0 ? 8 : (relv == 2 ? (vq < 4 ? 0 : (vq < 20 ? 5 : 4)) : 4);
                auto mk = [&](int i) __attribute__((always_inline)) -> att::UnitP {
                    const bool xtra = (relv == 2 && i == 4);
                    const int bh = relv == 0 ? ((vcu >> 1) & 63) : (xtra ? 8 * (vcu >> 5) : (vcu >> 2)), sub = relv == 0 ? ((vcu & 1) * 8 + i) : (xtra ? (vq - 4) : ((vcu & 3) * 4 + i)), b = bh >> 4, h = bh & 15;
                    att::UnitP P{}; P.tfill = (i == 0) || xtra;
                    if (relv == 0) {
                        const int part = vcu >> 7, dil = part == 0 ? 1 : 4, nqb = (SEQ / dil) / 256, res = sub / nqb, qb = sub % nqb;
                        const size_t row0 = (size_t)b * SEQ + res;
                        P.Qp = QKV + row0 * 3072 + h * 64; P.Kp = P.Qp + 1024; P.Vp = P.Qp + 2048; P.qrs = P.krs = (long)dil * 3072;
                        P.q0 = qb * 256; const int tl = qb * 4 - 2; P.t_lo = tl & ~(tl >> 31); P.NT = qb * 4 + 4 - P.t_lo;
                        P.tg = TAB + ((size_t)part * 16 + h) * 4096; P.W = 128; P.tCmax = 128; P.tlen = 640; P.tsh = 128 - (P.q0 - 64 * P.t_lo);
                        P.Op = (part == 0 ? O1 : O2) + row0 * DM + h * 64; P.ors = (long)dil * DM;
                        P.ml_out = ML + (size_t)part * MTOK * 32 + (row0 * 16 + h) * 2; P.mls = (long)dil * 32;
                    } else if (relv == 1) {
                        const int res = sub; const size_t row0 = (size_t)b * SEQ + res;
                        P.Qp = QKV + row0 * 3072 + h * 64; P.Kp = P.Qp + 1024; P.Vp = P.Qp + 2048; P.qrs = P.krs = 16L * 3072;
                        P.q0 = 0; P.t_lo = 0; P.NT = 4;
                        P.tg = TAB + ((size_t)2 * 16 + h) * 4096; P.W = 128; P.tCmax = 128; P.tlen = 640; P.tsh = 128;
                        P.Op = O1 + row0 * DM + h * 64; P.ors = 16L * DM; P.mls = 16L * 32;
                        P.S1 = O1 + row0 * DM + h * 64; P.S2 = O2 + row0 * DM + h * 64;
                        P.ml1 = ML + (row0 * 16 + h) * 2; P.ml2 = ML + (size_t)MTOK * 32 + (row0 * 16 + h) * 2;
                    } else {
                        const int qb = sub, kh = h >> 2; const size_t row0 = (size_t)b * SEQ;
                        P.Qp = QB + row0 * DM + h * 64; P.qrs = DM; P.img = 1; P.Kp = KWI + (size_t)((b * 4 + kh) * 64) * 4096; P.Vp = VWI + (size_t)((b * 4 + kh) * 64) * 4096;
                        P.q0 = qb * 256; const int tl = qb * 4 - 8; P.t_lo = tl & ~(tl >> 31); P.NT = qb * 4 + 4 - P.t_lo;
                        P.tg = TAB + (size_t)h * 4096; P.W = 511; P.tCmax = 512; P.tlen = 1024; P.tsh = 512 - (P.q0 - 64 * P.t_lo);
                        P.Op = O1 + row0 * DM + h * 64; P.ors = DM;
                        P.gate = GATES + row0 * 64 + h * 3 + 2; P.grs = 64;
                    }
                    return P; };
                att::bf16x8 qrc[4]; { _Pragma("unroll") for (int d_ = 0; d_ < 4; ++d_) { att::u32x4 t_; asm volatile("" : "=v"(t_)); qrc[d_] = __builtin_bit_cast(att::bf16x8, t_); } }     unsigned long long mkc = ~0ull;
#pragma unroll 1
                for (int i = 0; i < ni; ++i) {
                    const bool seam = (i + 1 < ni) && !(relv == 2 && i == 3);
                    att::UnitP P = mk(i); P.pre = (i > 0) && !(relv == 2 && i == 4);
                    if (seam) { const att::UnitP N = mk(i + 1); P.nQp = N.Qp; P.nKp = N.Kp; P.nVp = N.Vp; P.nq0 = N.q0; P.ntlo = N.t_lo; P.nNT = N.NT;
                        P.ncont = (relv != 2 && N.Kp == P.Kp && N.Vp == P.Vp && N.t_lo > P.t_lo && N.t_lo <= P.t_lo + P.NT && N.t_lo + N.NT <= P.t_lo + 10) ? 1 : 0; }
                    if (relv == 2) att::attn_unit<att::HK_REL, 8, false>(P, (char*)lds, wave_s, qrc, mkc);
                    else att::attn_unit<att::HK_REL, 8, true>(P, (char*)lds, wave_s, qrc, mkc);
                }
                did = true;
            }
        }
        if (L == 1 && st == 3) {
            cmp::CmpP CP{QB, DM, KCMP, VCMP, rel, O1, SEL, GATES};
            for (int k = 0; k < 4; ++k) { const int tb0 = vcu & 63; cmp::cmp_unit(CP, 4 * k + (vcu >> 6), (k & 1) ? 63 - tb0 : tb0, (char*)lds, wave_s, k == 0); }
            did = true;
        }
        {
            const int mv = (L == 1 && st == 4) ? 0 : ((L == 3 && st == 1) ? 1 : -1);
            if (mv >= 0) {
                auto mk = [&](int i) __attribute__((always_inline)) -> att::UnitP {
                    const int bh = vcu >> 2, s = 2 * (vcu & 3) + (i >> 1), b = bh >> 4, h = bh & 15, kh = h >> 2;
                    {
                        const int k = i & 1; const int qb = k == 0 ? s : 15 - s;
                        att::UnitP P{}; P.tfill = (i == 0); P.tCmax = 3840; P.toff = 2496; P.tlen = 4352 - 2496;
                        const size_t row0 = (size_t)b * SEQ;
                        P.q0 = qb * 256; P.t_lo = 0; P.NT = 4 * (qb + 1); P.tg = TAB + (size_t)h * 4096; P.W = 1 << 20; P.tsh = 3840 - P.q0;
                        P.Op = O1 + row0 * DM + h * 64; P.ors = DM;
                        if (mv == 0) {
                            P.Qp = QB + row0 * DM + h * 64; P.qrs = DM; P.img = 1; P.Kp = KSI + (size_t)((b * 4 + kh) * 64) * 4096; P.Vp = VSI + (size_t)((b * 4 + kh) * 64) * 4096;
                            P.mshift = 0; P.mask64 = SEL + (size_t)(b * 4 + kh) * SEQ;
                            P.S1 = P.Op; P.accum = 1; P.gate = GATES + row0 * 64 + h * 3 + 1; P.grs = 64;
                        } else {
                            P.Qp = QB + row0 * DM + h * 64; P.qrs = DM; P.img = 1; P.Kp = KI + (size_t)(bh * 64) * 4096; P.Vp = VI + (size_t)(bh * 64) * 4096;
                            P.mshift = 2; P.kmean = KMEAN + (size_t)bh * 1024; P.qb = qb;
                        }
                        return P;
                    } };
                att::bf16x8 qrc[4]; { _Pragma("unroll") for (int d_ = 0; d_ < 4; ++d_) { att::u32x4 t_; asm volatile("" : "=v"(t_)); qrc[d_] = __builtin_bit_cast(att::bf16x8, t_); } }     unsigned long long mkc = ~0ull;
#pragma unroll 1
                for (int i = 0; i < 4; ++i) {
                    att::UnitP P = mk(i); P.pre = (i > 0);
                    if (i + 1 < 4) { const att::UnitP N = mk(i + 1); P.nQp = N.Qp; P.nKp = N.Kp; P.nVp = N.Vp; P.nq0 = N.q0; P.ntlo = N.t_lo; P.nNT = N.NT; }
                    att::attn_unit<att::HK_RELMASK, 8>(P, (char*)lds, wave_s, qrc, mkc);
                }
                did = true;
            }
        }
        if (L == 2 && st == 1) {
            auto mk = [&](int i) __attribute__((always_inline)) -> att::UnitP {
                const int bh = vcu >> 2, s = 2 * (vcu & 3) + (i >> 1), b = bh >> 4, h = bh & 15;
                {
                    const int k = i & 1; const int qb = k == 0 ? s : 15 - s;
                    att::UnitP P{}; P.tfill = (i == 0);
                    const size_t row0 = (size_t)b * SEQ;
                    P.Qp = QB + row0 * DM + h * 64; P.qrs = DM; P.img = 1; P.Kp = KI + (size_t)(bh * 64) * 4096; P.Vp = VI + (size_t)(bh * 64) * 4096;
                    P.q0 = qb * 256; P.t_lo = 0; P.NT = 4 * (qb + 1);
                    P.cseq = FLOG + (size_t)bh * SEQ;
                    P.Op = O1 + row0 * DM + h * 64; P.ors = DM;
                    return P;
                } };
            att::bf16x8 qrc[4]; { _Pragma("unroll") for (int d_ = 0; d_ < 4; ++d_) { att::u32x4 t_; asm volatile("" : "=v"(t_)); qrc[d_] = __builtin_bit_cast(att::bf16x8, t_); } }     unsigned long long mkc = ~0ull;
#pragma unroll 1
            for (int i = 0; i < 4; ++i) {
                att::UnitP P = mk(i); P.pre = (i > 0);
                if (i + 1 < 4) { const att::UnitP N = mk(i + 1); P.nQp = N.Qp; P.nKp = N.Kp; P.nVp = N.Vp; P.nq0 = N.q0; P.ntlo = N.t_lo; P.nNT = N.NT; }
                att::attn_unit<att::HK_FOX, 8>(P, (char*)lds, wave_s, qrc, mkc);
            }
            did = true;
        }
        if (st == 5 || st == 7) {
            const bool c = (st == 5);
            pg8::Gemm g{c ? O1 : HB, c ? Wout : Wdn, MTOK, DM, c ? DM : FF, c ? DM : FF, c ? 0 : 1};   pg8::StaticOrder S; S.init(MTOK, DM, G, bx);
            if (c && L == 0) { pg8::EpiRes<true, false> E{x_in, nullptr, XB, rssB}; pg8::gemm_phase<pg8::EpiRes<true, false>, pg8::StaticOrder, true, true>(ldsL, g, S, E, wave_s); }
            else if (!c && L == 3) { pg8::EpiRes<false, true> E{nullptr, xres, XB, nullptr}; pg8::gemm_phase<pg8::EpiRes<false, true>, pg8::StaticOrder, true, true>(ldsL, g, S, E, wave_s); }
            else { pg8::EpiRes<false, false> E{nullptr, nullptr, XB, c ? rssB : rssA}; pg8::gemm_phase<pg8::EpiRes<false, false>, pg8::StaticOrder, true, true>(ldsL, g, S, E, wave_s); }
            did = true;
        }
        if (st == 6) {
            pg8::Gemm g{XB, Wup, MTOK, FF, DM, DM, 1}; pg8::StaticOrder S; S.init(MTOK, FF, G, bx);
            auto pre = [&](int tid) __attribute__((always_inline)) { pg8::rstd_prepass(S, rssB, (LAS float*)(ldsL + LDS_RSTD), tid); };
            pg8::EpiUp E{HB, (const LAS float*)(ldsL + LDS_RSTD)};
            pg8::gemm_phase<pg8::EpiUp, pg8::StaticOrder, true, true>(ldsL, g, S, E, wave_s, pre);
            did = true;
        }
        if (did && !(L == 3 && st == 7)) XBAR();
      }
    }
}

extern "C" void kernel_launch(void* const* d_in, const int* in_sizes, int n_in, void* d_out, int out_size, void* d_ws, size_t ws_size, hipStream_t stream) {
    static int grid = 0;
    if (grid == 0) {
        if (n_in != 17 || out_size != MTOK * DM || ws_size < WS_END) { fprintf(stderr, "kernel_launch: unexpected problem (n_in %d, out %d, ws %zu)\n", n_in, out_size, ws_size); grid = -1; return; }
        int dev = 0, cus = 0, per_cu = 0;
        (void)hipGetDevice(&dev); (void)hipDeviceGetAttribute(&cus, hipDeviceAttributeMultiprocessorCount, dev);
        if (hipFuncSetAttribute((const void*)fwd_mega, hipFuncAttributeMaxDynamicSharedMemorySize, LDS_BYTES) != hipSuccess) { fprintf(stderr, "kernel_launch: hipFuncSetAttribute failed\n"); grid = -1; return; }
        if (hipOccupancyMaxActiveBlocksPerMultiprocessor(&per_cu, (const void*)fwd_mega, 512, LDS_BYTES) != hipSuccess || per_cu < 1) { fprintf(stderr, "kernel_launch: occupancy query says %d\n", per_cu); per_cu = 1; }
        (void)hipGetLastError();
        if (per_cu < 1 || cus * per_cu < 256) { fprintf(stderr, "kernel_launch: needs 256 co-resident workgroups, device offers %d x %d\n", cus, per_cu); grid = -1; return; }
        grid = 256;
    }
    if (grid < 0) return;
    Args a{};
    for (int i = 0; i < 17; ++i) a.in[i] = (const float*)d_in[i];
    a.out = (float*)d_out; a.ws = (unsigned char*)d_ws;
    if (hipMemsetAsync((char*)d_ws + WS_BAR, 0, XCD_BAR_WORDS * 4, stream) != hipSuccess) { fprintf(stderr, "kernel_launch: memset of the barrier words failed\n"); return; }
    void* kargs[] = {&a};
    hipError_t e = hipLaunchCooperativeKernel((const void*)fwd_mega, dim3(grid), dim3(512), kargs, LDS_BYTES, stream);
    if (e != hipSuccess) fprintf(stderr, "cooperative launch failed: %s (grid %d)\n", hipGetErrorString(e), grid);
}
```

```cpp
#include <hip/hip_runtime.h>
#include <hip/hip_cooperative_groups.h>
#include <cstdio>
#include <cstdint>
#include <cmath>
namespace cg = cooperative_groups;

constexpr int BATCH = 4, SEQ = 4096, DM = 1024, NH = 16, HD = 64, FF = 4096, MTOK = BATCH * SEQ;
constexpr float RMS_EPS = 1e-6f;
constexpr float LOG2E = 1.4426950408889634f;
constexpr float C2 = 0.125f * LOG2E;
constexpr int NSA_N = 2608, NSA_NP = 2816;
constexpr int FOX_LDW = 3088;

#define LAS __attribute__((address_space(3)))

__device__ __forceinline__ float shx(float v, int m, int lane) { return __int_as_float(__builtin_amdgcn_ds_bpermute((lane ^ m) << 2, __float_as_int(v))); }
__device__ __forceinline__ float opaque_zero() { int z = 0; asm volatile("" : "+v"(z)); return __int_as_float(z); }

__device__ __forceinline__ int lane_id_v() { int l; asm volatile("v_mbcnt_lo_u32_b32 %0, -1, 0\n\tv_mbcnt_hi_u32_b32 %0, -1, %0" : "=v"(l)); return l; }

namespace pg8 {
#define PG8_LAS __attribute__((address_space(3)))
typedef unsigned short bf16_t;
typedef short bf16x8 __attribute__((ext_vector_type(8)));
typedef float f32x4 __attribute__((ext_vector_type(4)));
typedef unsigned u32x4 __attribute__((ext_vector_type(4)));
constexpr int BM = 256, BK = 64, HALF = 128, HTB = HALF * BK * 2  , STAGE_BYTES = 8 * HTB, NXCD = 8, WGM = 8;

__host__ __device__ __forceinline__ int lds_byte(int r, int c) { const int st = (r >> 4) * 2 + (c >> 5), rr = r & 15, cc = c & 31, ob = rr * 64 + cc * 2; return st * 1024 + (ob ^ (((ob >> 9) & 1) << 5)); }
__host__ __device__ __forceinline__ void stage_rc(int b, int& R, int& C) { const int st = b / 1024, sb = b % 1024, swz = sb ^ (((sb >> 9) & 1) << 5); R = (st >> 1) * 16 + swz / 64; C = (st & 1) * 32 + (swz % 64) / 2; }
__host__ __device__ __forceinline__ int perm32(int rho) { const int n = rho >> 4, i = rho & 15; return 8 * (i >> 2) + 4 * n + (i & 3); }

struct Unit { int pm, pn; };
struct Gemm { const bf16_t* A; const bf16_t* Bt; int M, N, K, lda; int ablk; };

struct StaticOrder {
    int nM, nN, nwg, G, c;
    __host__ __device__ void init(int M, int N, int G_, int c_) { nM = M / BM; nN = N / BM; nwg = nM * nN; G = G_; c = c_; }
    __host__ __device__ __forceinline__ bool next(int i, Unit& u) const {
        const long L = (long)i * G + c; if (L >= nwg) return false;
        int wgid = (int)L; { const int q = nwg / NXCD, r = nwg % NXCD, xcd = wgid % NXCD, off = wgid / NXCD; wgid = (xcd < r ? xcd * (q + 1) : r * (q + 1) + (xcd - r) * q) + off; }
        const int nig = WGM * nN, gid = wgid / nig, fm = gid * WGM, gsz = (nM - fm) < WGM ? (nM - fm) : WGM;
        u.pm = fm + ((wgid % nig) % gsz); u.pn = (wgid % nig) / gsz; return true;
    }
    __device__ __forceinline__ void a_ready(const Unit&) const {}
    __device__ __forceinline__ void done(const Unit&) const {}
};


__device__ __forceinline__ unsigned cvt_pk_bf16(float lo, float hi) { unsigned r; asm volatile("v_cvt_pk_bf16_f32 %0, %1, %2" : "=v"(r) : "v"(lo), "v"(hi)); return r; }
__device__ __forceinline__ float hsum4(const f32x4 v) { return (v[0] + v[1]) + (v[2] + v[3]); }
__device__ __forceinline__ float hsq4(const f32x4 v) { return (v[0] * v[0] + v[1] * v[1]) + (v[2] * v[2] + v[3] * v[3]); }
__device__ __forceinline__ float row_rstd(const float* rss, int row) {
    const f32x4* rp = (const f32x4*)(rss + (size_t)row * 16);
    const f32x4 s0 = rp[0], s1 = rp[1], s2 = rp[2], s3 = rp[3];
    const float tot = (hsum4(s0) + hsum4(s1)) + (hsum4(s2) + hsum4(s3));
    return rsqrtf(tot * (1.0f / 1024.0f) + RMS_EPS);
}
struct EpiIn {
    static constexpr bool PERM = true, AFTER_DRAIN = false;
    bf16_t* O; int ldc; const PG8_LAS float* rstdL; const PG8_LAS float* qg; const PG8_LAS float* kg; unsigned long long modes;
    bf16_t* slab0; bf16_t* slab1; int slab_tile0; float* kmean;
    unsigned long long dk, isel, ih0; int hpb; bf16_t* iA; bf16_t* iB; bf16_t* iC; bf16_t* iD; bf16_t* gates;
    __device__ __forceinline__ void operator()(const f32x4 (&acc)[2][2][4][2], const Unit& u, int ui, int wr, int wc, int fr, int fq) const {
        const int mode = (int)((modes >> (2 * u.pn)) & 3ull);
        const int dkind = (int)((dk >> (3 * u.pn)) & 7ull);
        const int row0 = u.pm * BM + wr * 64 + fr;
        const int tcol = u.pn * BM + wc * 64 + 8 * fq;
        const bool nrm = (mode == 1 || mode == 2);
        f32x4 gv[2][2];
#pragma unroll
        for (int bj = 0; bj < 2; ++bj)
#pragma unroll
            for (int n = 0; n < 2; ++n) gv[bj][n] = (f32x4){1.f, 1.f, 1.f, 1.f};
        if (nrm) { const PG8_LAS float* gp = (mode == 1) ? qg : kg; const float sc = (mode == 1) ? C2 : 1.f;
#pragma unroll
            for (int bj = 0; bj < 2; ++bj)
#pragma unroll
                for (int n = 0; n < 2; ++n) gv[bj][n] = *(const PG8_LAS f32x4*)(gp + bj * 32 + 8 * fq + 4 * n) * sc; }
        const bool km = (kmean != nullptr) && (mode == 2);
        f32x4 cs[2][2];
#pragma unroll
        for (int bj = 0; bj < 2; ++bj)
#pragma unroll
            for (int n = 0; n < 2; ++n) cs[bj][n] = (f32x4){0.f, 0.f, 0.f, 0.f};
#pragma unroll
        for (int ai = 0; ai < 2; ++ai) {
            float rs4[4];
#pragma unroll
            for (int m = 0; m < 4; ++m) rs4[m] = rstdL[ui * 256 + ai * HALF + wr * 64 + m * 16 + fr];
            if (nrm) {
                float ss4[4], t4[4]; const int ln_ = fq * 16 + fr;
#pragma unroll
                for (int m = 0; m < 4; ++m) { const float rstd = rs4[m];
                    const f32x4 a0 = acc[ai][0][m][0] * rstd, a1 = acc[ai][0][m][1] * rstd, a2 = acc[ai][1][m][0] * rstd, a3 = acc[ai][1][m][1] * rstd;
                    ss4[m] = (hsq4(a0) + hsq4(a1)) + (hsq4(a2) + hsq4(a3)); }
#pragma unroll
                for (int m = 0; m < 4; ++m) t4[m] = shx(ss4[m], 16, ln_);
#pragma unroll
                for (int m = 0; m < 4; ++m) ss4[m] += t4[m];
#pragma unroll
                for (int m = 0; m < 4; ++m) t4[m] = shx(ss4[m], 32, ln_);
#pragma unroll
                for (int m = 0; m < 4; ++m) rs4[m] *= rsqrtf((ss4[m] + t4[m]) * (1.0f / 64.0f) + RMS_EPS);
            }
#pragma unroll
            for (int m = 0; m < 4; ++m) {
                const int row = row0 + ai * HALF + m * 16;
                const float rstd = rs4[m];
                f32x4 v[2][2];
#pragma unroll
                for (int bj = 0; bj < 2; ++bj)
#pragma unroll
                    for (int n = 0; n < 2; ++n) v[bj][n] = acc[ai][bj][m][n] * rstd * gv[bj][n];
                if (km) {
#pragma unroll
                    for (int bj = 0; bj < 2; ++bj)
#pragma unroll
                        for (int n = 0; n < 2; ++n) cs[bj][n] += v[bj][n];
                }
                u32x4 wA, wB;
                wA.x = cvt_pk_bf16(v[0][0][0], v[0][0][1]); wA.y = cvt_pk_bf16(v[0][0][2], v[0][0][3]); wA.z = cvt_pk_bf16(v[0][1][0], v[0][1][1]); wA.w = cvt_pk_bf16(v[0][1][2], v[0][1][3]);
                wB.x = cvt_pk_bf16(v[1][0][0], v[1][0][1]); wB.y = cvt_pk_bf16(v[1][0][2], v[1][0][3]); wB.z = cvt_pk_bf16(v[1][1][0], v[1][1][1]); wB.w = cvt_pk_bf16(v[1][1][2], v[1][1][3]);
                if (dkind == 0) {
                u32x4 xB, yA;
#pragma unroll
                for (int k = 0; k < 4; ++k) { xB[k] = (unsigned)__builtin_amdgcn_update_dpp(0, (int)wB[k], 0x128, 0xf, 0xf, false); yA[k] = (unsigned)__builtin_amdgcn_update_dpp(0, (int)wA[k], 0x128, 0xf, 0xf, false); }
                const bool up = fr >= 8;
                const u32x4 d1 = up ? xB : wA, d2 = up ? wB : yA;
                const int rbase = row - fr + (fr & 7);
                bf16_t* p1; bf16_t* p2;
                if (mode == 3) { bf16_t* sb = (u.pn == slab_tile0) ? slab0 : slab1; const int b = rbase / SEQ, t = rbase % SEQ;
                    p1 = sb + ((size_t)((b * 4 + wc) * SEQ + t)) * 64 + 8 * fq + (up ? 32 : 0); p2 = p1 + 8 * 64; }
                else { p1 = O + (size_t)rbase * ldc + tcol + (up ? 32 : 0); p2 = p1 + (size_t)8 * ldc; }
                *(u32x4*)p1 = d1; *(u32x4*)p2 = d2;
                } else if (dkind == 4) {
                    if (wc == 0) { bf16_t* p = gates + (size_t)row * 64 + 8 * fq; *(u32x4*)p = wA; *(u32x4*)(p + 32) = wB; }
                } else {
                    const int b = row / SEQ, t = row % SEQ;
                    const int is_ = (int)((isel >> (3 * u.pn)) & 7ull), h0_ = (int)((ih0 >> (4 * u.pn)) & 15ull);
                    bf16_t* ib = is_ == 0 ? iA : (is_ == 1 ? iB : (is_ == 2 ? iC : iD));
                    bf16_t* tb = ib + ((size_t)((b * hpb + (u.pn - h0_) * 4 + wc) * 64 + (t >> 6))) * 4096;
                    bf16_t* pA = (dkind == 1) ? tb + fq * 512 + (t & 63) * 8 : tb + m * 512 + fr * 32 + fq * 8;
                    *(u32x4*)pA = wA; *(u32x4*)(pA + 4 * 512) = wB;
                }
            }
        }
        if (km) {
            const int b = u.pm / 16, blk = u.pm % 16, h = (u.pn - 4) * 4 + wc;
            float* kp = kmean + ((size_t)((b * 16 + h) * 16 + blk)) * 64 + 8 * fq;
#pragma unroll
            for (int bj = 0; bj < 2; ++bj)
#pragma unroll
                for (int n = 0; n < 2; ++n)
#pragma unroll
                    for (int i = 0; i < 4; ++i) { float s = cs[bj][n][i];
                        { const int ln_ = fq * 16 + fr; s += shx(s, 1, ln_); s += shx(s, 2, ln_); s += shx(s, 4, ln_); s += shx(s, 8, ln_); }
                        if (fr == 0) atomicAdd(kp + bj * 32 + 4 * n + i, s); }
        }
    }
};
template <bool BASE_F32, bool OUT_F32> struct EpiRes {
    static constexpr bool PERM = true, AFTER_DRAIN = false;
    const float* base32; float* out32; bf16_t* xb; float* rss_out;
    __device__ __forceinline__ void operator()(const f32x4 (&acc)[2][2][4][2], const Unit& u, int ui, int wr, int wc, int fr, int fq) const {
        const int row0 = u.pm * BM + wr * 64 + fr, col0 = u.pn * BM + wc * 32 + 8 * fq;
        u32x4 raw[2][4][2];
        if (!BASE_F32) {
#pragma unroll
            for (int ai = 0; ai < 2; ++ai)
#pragma unroll
                for (int m = 0; m < 4; ++m)
#pragma unroll
                    for (int bj = 0; bj < 2; ++bj) { const size_t offb = (size_t)((u.pm * 16 + wr * 4 + ai * 8 + m) * (DM / 32) + (u.pn * 8 + bj * 4 + wc)) * 512 + fr * 32 + 8 * fq;
                        raw[ai][m][bj] = *(const u32x4*)(xb + offb); }
        }
#pragma unroll
        for (int ai = 0; ai < 2; ++ai) {
            f32x4 pre[4][2][2];
#pragma unroll
            for (int m = 0; m < 4; ++m)
#pragma unroll
                for (int bj = 0; bj < 2; ++bj) { const size_t off = (size_t)(row0 + ai * HALF + m * 16) * DM + col0 + bj * HALF;
                    if (BASE_F32) { pre[m][bj][0] = *(const f32x4*)(base32 + off); pre[m][bj][1] = *(const f32x4*)(base32 + off + 4); }
                    else { const u32x4 w = raw[ai][m][bj];
                        pre[m][bj][0] = (f32x4){__uint_as_float(w.x << 16), __uint_as_float(w.x & 0xffff0000u), __uint_as_float(w.y << 16), __uint_as_float(w.y & 0xffff0000u)};
                        pre[m][bj][1] = (f32x4){__uint_as_float(w.z << 16), __uint_as_float(w.z & 0xffff0000u), __uint_as_float(w.w << 16), __uint_as_float(w.w & 0xffff0000u)}; } }
#pragma unroll
            for (int m = 0; m < 4; ++m) {
                const int row = row0 + ai * HALF + m * 16; float ss = 0.f;
#pragma unroll
                for (int bj = 0; bj < 2; ++bj) { const size_t off = (size_t)row * DM + col0 + bj * HALF;
                    const size_t offb = (size_t)((u.pm * 16 + wr * 4 + ai * 8 + m) * (DM / 32) + (u.pn * 8 + bj * 4 + wc)) * 512 + fr * 32 + 8 * fq;
                    const f32x4 v0 = acc[ai][bj][m][0] + pre[m][bj][0], v1 = acc[ai][bj][m][1] + pre[m][bj][1];
                    if (OUT_F32) { *(f32x4*)(out32 + off) = v0; *(f32x4*)(out32 + off + 4) = v1; }
                    else { u32x4 w; w.x = cvt_pk_bf16(v0[0], v0[1]); w.y = cvt_pk_bf16(v0[2], v0[3]); w.z = cvt_pk_bf16(v1[0], v1[1]); w.w = cvt_pk_bf16(v1[2], v1[3]);
                        *(u32x4*)(xb + offb) = w; }
                    ss += hsq4(v0) + hsq4(v1); }
                if (!OUT_F32) { ss += shx(ss, 16, fq * 16 + fr); ss += shx(ss, 32, fq * 16 + fr);
                    if (fq == 0) rss_out[(size_t)row * 16 + u.pn * 4 + wc] = ss; }
            }
        }
    }
};
template <class Sched> __device__ __forceinline__ void rstd_prepass(const Sched& S, const float* rss, PG8_LAS float* rstdL, int tid) {
    Unit u;
    for (int i = 0; S.next(i, u); ++i) if (tid < 256) rstdL[i * 256 + tid] = row_rstd(rss, u.pm * BM + tid);
}
struct EpiUp {
    static constexpr bool PERM = true, AFTER_DRAIN = false;
    bf16_t* O; const PG8_LAS float* rstdL;
    __device__ __forceinline__ void operator()(const f32x4 (&acc)[2][2][4][2], const Unit& u, int ui, int wr, int wc, int fr, int fq) const {
        const int row0 = u.pm * BM + wr * 64 + fr, col0 = u.pn * BM + wc * 32 + 8 * fq;
#pragma unroll
        for (int ai = 0; ai < 2; ++ai)
#pragma unroll
            for (int m = 0; m < 4; ++m) {
                const int row = row0 + ai * HALF + m * 16; const float rstd = rstdL[ui * 256 + ai * HALF + wr * 64 + m * 16 + fr];
#pragma unroll
                for (int bj = 0; bj < 2; ++bj) { f32x4 v0 = acc[ai][bj][m][0] * rstd, v1 = acc[ai][bj][m][1] * rstd;
#pragma unroll
                    for (int i = 0; i < 4; ++i) { const float a = fmaxf(v0[i], 0.f), b = fmaxf(v1[i], 0.f); v0[i] = a * a; v1[i] = b * b; }
                    u32x4 w; w.x = cvt_pk_bf16(v0[0], v0[1]); w.y = cvt_pk_bf16(v0[2], v0[3]); w.z = cvt_pk_bf16(v1[0], v1[1]); w.w = cvt_pk_bf16(v1[2], v1[3]);
                    *(u32x4*)(O + ((size_t)((u.pm * 16 + wr * 4 + ai * 8 + m) * (FF / 32) + (u.pn * 8 + bj * 4 + wc)) * 512 + fr * 32 + 8 * fq)) = w; }
            }
    }
};
__device__ __forceinline__ float gelu_tanh(float x) {
    const float u = 0.7978845608028654f * (x + 0.044715f * x * x * x);
    const float e = __expf(2.f * u);
    const float th = 1.f - 2.f / (e + 1.f);
    return 0.5f * x * (1.f + th);
}
struct EpiCmp {
    static constexpr bool PERM = true, AFTER_DRAIN = false;
    bf16_t* O; const float* posb;
    __device__ __forceinline__ void operator()(const f32x4 (&acc)[2][2][4][2], const Unit& u, int ui, int wr, int wc, int fr, int fq) const {
        const int row0 = u.pm * BM + wr * 64 + fr, col0 = wc * 32 + 8 * fq;
        f32x4 bv[2][2];
#pragma unroll
        for (int bj = 0; bj < 2; ++bj)
#pragma unroll
            for (int n = 0; n < 2; ++n) bv[bj][n] = *(const f32x4*)(posb + col0 + bj * HALF + 4 * n);
#pragma unroll
        for (int ai = 0; ai < 2; ++ai)
#pragma unroll
            for (int m = 0; m < 4; ++m) {
                const int row = row0 + ai * HALF + m * 16;
#pragma unroll
                for (int bj = 0; bj < 2; ++bj) { f32x4 v0 = acc[ai][bj][m][0] + bv[bj][0], v1 = acc[ai][bj][m][1] + bv[bj][1];
#pragma unroll
                    for (int i = 0; i < 4; ++i) { v0[i] = gelu_tanh(v0[i]); v1[i] = gelu_tanh(v1[i]); }
                    u32x4 w; w.x = cvt_pk_bf16(v0[0], v0[1]); w.y = cvt_pk_bf16(v0[2], v0[3]); w.z = cvt_pk_bf16(v1[0], v1[1]); w.w = cvt_pk_bf16(v1[2], v1[3]);
                    *(u32x4*)(O + (size_t)row * 256 + col0 + bj * HALF) = w; }
            }
    }
};

struct NoPre { __device__ __forceinline__ void operator()(int) const {} };
template <class Epi, class Sched, bool ALIGN_EPI = false, bool SP2 = false, class Pre = NoPre>
__device__ __forceinline__ void gemm_phase(PG8_LAS unsigned char* lds, const Gemm g, const Sched& S, const Epi& E, const int wave_s, const Pre& pre = Pre()) {
    int wid_l = wave_s; asm volatile("" : "+s"(wid_l));
    const int lane = lane_id_v(), wid = wid_l, tid = wid * 64 + lane, wr = wid >> 2, wc = wid & 3, fr = lane & 15, fq = lane >> 4;
    const int K = g.K, nt = K / BK;
    unsigned voffA[2], voffB[2];
#pragma unroll
    for (int i = 0; i < 2; ++i) { int R, C; stage_rc(tid * 16 + i * 8192, R, C); const int Rb = Epi::PERM ? ((R & ~31) + perm32(R & 31)) : R;
        voffA[i] = g.ablk ? (unsigned)((R >> 4) * (K / 32) * 1024 + (R & 15) * 64 + (C >> 5) * 1024 + (C & 31) * 2) : (unsigned)(R * g.lda + C) * 2u;   voffB[i] = (unsigned)((Rb >> 4) * (K / 32) * 1024 + (Rb & 15) * 64 + (C >> 5) * 1024 + (C & 31) * 2); }
    const size_t kstepB = (size_t)2048, kstepA = g.ablk ? (size_t)2048 : (size_t)(BK * 2);
    const size_t hstepA = (size_t)HALF * g.lda * 2, hstepB = (size_t)HALF * K * 2;
    const size_t tstepA = 2 * hstepA, tstepB = 2 * hstepB;
    const unsigned ldsw = (unsigned)wid * 1024u;
    const int aoff = lds_byte(wr * 64 + fr, fq * 8), boff = lds_byte(wc * 32 + fr, fq * 8);
#define PG8_SA(b, h) (((b) * 2 + (h)) * HTB)
#define PG8_SB(b, h) ((4 + (b) * 2 + (h)) * HTB)
#define PG8_STAGE(bufoff, gbase, voff) do { _Pragma("unroll") for (int _i = 0; _i < 2; ++_i) \
        __builtin_amdgcn_global_load_lds((const unsigned*)((const char*)(gbase) + (voff)[_i]), (PG8_LAS unsigned*)(lds + (bufoff) + ldsw + _i * 8192), 16, 0, 0); } while (0)
#define PG8_LDA(dst, b, h) do { _Pragma("unroll") for (int m = 0; m < 4; ++m) _Pragma("unroll") for (int k = 0; k < 2; ++k) dst[m][k] = *(const PG8_LAS bf16x8*)(lds + PG8_SA(b, h) + aoff + m * 2048 + k * 1024); } while (0)
#define PG8_LDB(dst, b, h) do { _Pragma("unroll") for (int n = 0; n < 2; ++n) _Pragma("unroll") for (int k = 0; k < 2; ++k) dst[n][k] = *(const PG8_LAS bf16x8*)(lds + PG8_SB(b, h) + boff + n * 2048 + k * 1024); } while (0)
#define PG8_MMA(ai, bj, At, Bt) do { __builtin_amdgcn_s_setprio(1); _Pragma("unroll") for (int m = 0; m < 4; ++m) _Pragma("unroll") for (int n = 0; n < 2; ++n) _Pragma("unroll") for (int k = 0; k < 2; ++k) \
        acc[ai][bj][m][n] = __builtin_amdgcn_mfma_f32_16x16x32_bf16(Bt[n][k], At[m][k], acc[ai][bj][m][n], 0, 0, 0); __builtin_amdgcn_s_setprio(0); } while (0)
#define PG8_WAIT_V(n) asm volatile("s_waitcnt vmcnt(" #n ")" ::: "memory")
#define PG8_WAIT_L(n) asm volatile("s_waitcnt lgkmcnt(" #n ")" ::: "memory")
#define PG8_BAR __builtin_amdgcn_s_barrier()
#define PG8_SCHED __builtin_amdgcn_sched_barrier(0)
    Unit cur, nxt; int ui = 0;
    if (!S.next(0, cur)) return;
    f32x4 acc[2][2][4][2];
#pragma unroll
    for (int a = 0; a < 2; ++a)
#pragma unroll
        for (int b = 0; b < 2; ++b)
#pragma unroll
            for (int m = 0; m < 4; ++m)
#pragma unroll
                for (int n = 0; n < 2; ++n) acc[a][b][m][n] = (f32x4){0.f, 0.f, 0.f, 0.f};
    bf16x8 At[4][2], B0[2][2], B1[2][2];
    const char* cA = (const char*)g.A + (size_t)cur.pm * tstepA; const char* cB = (const char*)g.Bt + (size_t)cur.pn * tstepB;
    S.a_ready(cur);
    if constexpr (SP2) {
        PG8_STAGE(PG8_SB(0, 0), cB, voffB); PG8_STAGE(PG8_SB(0, 1), cB + hstepB, voffB); PG8_STAGE(PG8_SA(0, 0), cA, voffA); PG8_STAGE(PG8_SA(0, 1), cA + hstepA, voffA);
        pre(tid);
        if (wr == 1) PG8_BAR;
        PG8_WAIT_V(2); PG8_BAR;
        PG8_STAGE(PG8_SB(1, 0), cB + kstepB, voffB); PG8_STAGE(PG8_SA(1, 0), cA + kstepA, voffA); PG8_STAGE(PG8_SB(1, 1), cB + hstepB + kstepB, voffB);
        PG8_WAIT_V(6); PG8_BAR;
    } else {
        PG8_STAGE(PG8_SB(0, 0), cB, voffB); PG8_STAGE(PG8_SA(0, 0), cA, voffA); PG8_STAGE(PG8_SB(0, 1), cB + hstepB, voffB); PG8_STAGE(PG8_SA(0, 1), cA + hstepA, voffA);
        if (wr == 1) PG8_BAR;
        PG8_WAIT_V(4); PG8_BAR;
        PG8_STAGE(PG8_SB(1, 0), cB + kstepB, voffB); PG8_STAGE(PG8_SA(1, 0), cA + kstepA, voffA); PG8_STAGE(PG8_SB(1, 1), cB + hstepB + kstepB, voffB);
        PG8_WAIT_V(6); PG8_BAR;
    }
    for (;;) {
        const bool has_next = S.next(ui + 1, nxt);
        const char* nA = has_next ? (const char*)g.A + (size_t)nxt.pm * tstepA : cA; const char* nB = has_next ? (const char*)g.Bt + (size_t)nxt.pn * tstepB : cB;
        for (int t = 0; t < nt; t += 2) {
            const bool last = (t == nt - 2);
            const char* a1 = cA + (size_t)(t + 1) * kstepA;
            const char* a2 = last ? nA : cA + (size_t)(t + 2) * kstepA; const char* b2 = last ? nB : cB + (size_t)(t + 2) * kstepB;
            const char* a3 = a2 + kstepA; const char* b3 = b2 + kstepB;
            if (last && has_next) S.a_ready(nxt);
            if constexpr (SP2) {
            PG8_LDB(B0, 0, 0); PG8_LDB(B1, 0, 1); PG8_SCHED; PG8_LDA(At, 0, 0); PG8_STAGE(PG8_SA(1, 1), a1 + hstepA, voffA);
            PG8_WAIT_V(8); PG8_WAIT_L(0); PG8_BAR; PG8_MMA(0, 0, At, B0); PG8_MMA(0, 1, At, B1); PG8_BAR; PG8_SCHED;
            PG8_LDA(At, 0, 1); PG8_STAGE(PG8_SB(0, 0), b2, voffB); PG8_STAGE(PG8_SB(0, 1), b2 + hstepB, voffB); PG8_STAGE(PG8_SA(0, 0), a2, voffA);
            PG8_WAIT_V(8); PG8_WAIT_L(0); PG8_BAR; PG8_MMA(1, 0, At, B0); PG8_MMA(1, 1, At, B1); PG8_BAR; PG8_SCHED;
            PG8_LDB(B0, 1, 0); PG8_LDB(B1, 1, 1); PG8_SCHED; PG8_LDA(At, 1, 0); PG8_STAGE(PG8_SA(0, 1), a2 + hstepA, voffA);
            PG8_WAIT_V(8); PG8_WAIT_L(0); PG8_BAR; PG8_MMA(0, 0, At, B0); PG8_MMA(0, 1, At, B1); PG8_BAR; PG8_SCHED;
            PG8_LDA(At, 1, 1); PG8_STAGE(PG8_SB(1, 0), b3, voffB); PG8_STAGE(PG8_SB(1, 1), b3 + hstepB, voffB); PG8_STAGE(PG8_SA(1, 0), a3, voffA);
            PG8_WAIT_V(8); PG8_WAIT_L(0); PG8_BAR; PG8_MMA(1, 0, At, B0); PG8_MMA(1, 1, At, B1); PG8_BAR; PG8_SCHED;
            } else {
            PG8_LDB(B0, 0, 0); PG8_SCHED; PG8_LDA(At, 0, 0); PG8_STAGE(PG8_SA(1, 1), a1 + hstepA, voffA);
            PG8_WAIT_L(8); PG8_BAR; PG8_WAIT_L(0); PG8_MMA(0, 0, At, B0); PG8_BAR; PG8_SCHED;
            PG8_LDB(B1, 0, 1); PG8_STAGE(PG8_SB(0, 0), b2, voffB);
            PG8_BAR; PG8_WAIT_L(0); PG8_MMA(0, 1, At, B1); PG8_BAR;
            PG8_LDA(At, 0, 1); PG8_STAGE(PG8_SA(0, 0), a2, voffA);
            PG8_BAR; PG8_WAIT_L(0); PG8_MMA(1, 0, At, B0); PG8_BAR; PG8_SCHED;
            PG8_STAGE(PG8_SB(0, 1), b2 + hstepB, voffB);
            PG8_WAIT_V(6); PG8_BAR; PG8_MMA(1, 1, At, B1); PG8_BAR;
            PG8_LDB(B0, 1, 0); PG8_SCHED; PG8_LDA(At, 1, 0); PG8_STAGE(PG8_SA(0, 1), a2 + hstepA, voffA);
            PG8_WAIT_L(8); PG8_BAR; PG8_WAIT_L(0); PG8_MMA(0, 0, At, B0); PG8_BAR; PG8_SCHED;
            PG8_LDB(B1, 1, 1); PG8_STAGE(PG8_SB(1, 0), b3, voffB);
            PG8_BAR; PG8_WAIT_L(0); PG8_MMA(0, 1, At, B1); PG8_BAR;
            PG8_LDA(At, 1, 1); PG8_STAGE(PG8_SA(1, 0), a3, voffA);
            PG8_BAR; PG8_WAIT_L(0); PG8_MMA(1, 0, At, B0); PG8_BAR; PG8_SCHED;
            PG8_STAGE(PG8_SB(1, 1), b3 + hstepB, voffB);
            PG8_WAIT_V(6); PG8_BAR; PG8_MMA(1, 1, At, B1); PG8_BAR;
            }
        }
        if constexpr (ALIGN_EPI) { if (wr == 0) PG8_BAR; }
        if constexpr (!Epi::AFTER_DRAIN) { E(acc, cur, ui, wr, wc, fr, fq); S.done(cur); }
        if (!has_next) break;
#pragma unroll
        for (int a = 0; a < 2; ++a)
#pragma unroll
            for (int b = 0; b < 2; ++b)
#pragma unroll
                for (int m = 0; m < 4; ++m)
#pragma unroll
                    for (int n = 0; n < 2; ++n) acc[a][b][m][n] = (f32x4){0.f, 0.f, 0.f, 0.f};
        cur = nxt; cA = nA; cB = nB; ++ui;
        if constexpr (ALIGN_EPI) { if (wr == 1) PG8_BAR; }
    }
    PG8_WAIT_V(0);
    if constexpr (!ALIGN_EPI) { if (wr == 0) PG8_BAR; }
    PG8_BAR;
    if constexpr (Epi::AFTER_DRAIN) { E.fused(acc, cur, wr, wc, fr, fq, lds, wid, lane); S.done(cur); }
#undef PG8_SA
#undef PG8_SB
#undef PG8_STAGE
#undef PG8_LDA
#undef PG8_LDB
#undef PG8_MMA
#undef PG8_WAIT_V
#undef PG8_WAIT_L
#undef PG8_BAR
#undef PG8_SCHED
}
}

namespace att {
typedef unsigned short bf16;
using bf16x8 = __attribute__((ext_vector_type(8))) short;
using s16x4 = __attribute__((ext_vector_type(4))) short;
using f32x16 = __attribute__((ext_vector_type(16))) float;
using f32x4 = __attribute__((ext_vector_type(4))) float;
using u32x4 = __attribute__((ext_vector_type(4))) unsigned;
constexpr int NW = 8, QBLK = 32, QB = QBLK * NW, KVBLK = 64;
constexpr int NSLOT = 3, SLOTB = 8192;
constexpr int LDS_K = 0, LDS_V = NSLOT * SLOTB, LDS_WS = 2 * NSLOT * SLOTB, LDS_OST = LDS_WS + NW * 128 * 4, LDS_TAB = LDS_OST + NW * 4096, TABQ = 1872  , LDS_KM = LDS_TAB + TABQ * 16, LDS_END = LDS_KM + 8192;
static_assert(LDS_END <= 131072, "attention LDS map");
__device__ __forceinline__ int crow(int r, int hi) { return (r & 3) + 8 * (r >> 2) + 4 * hi; }
#define SBAR() __builtin_amdgcn_sched_barrier(0)
__device__ __forceinline__ void cmask(f32x16& p0, f32x16& p1, int jb, int qrel, int hi) {
    const float NEG = -INFINITY; int thr = qrel - (64 * jb + 4 * hi); asm volatile("" : "+v"(thr));
#pragma unroll
    for (int r = 0; r < 16; ++r) { const int c = (r & 3) + 8 * (r >> 2); if (c > thr) p0[r] = NEG; if (c + 32 > thr) p1[r] = NEG; }
}
__device__ __forceinline__ void glds16(const void* gsrc, unsigned lds_dst) { unsigned keep;
    asm volatile("s_mov_b32 %0, m0\n\ts_mov_b32 m0, %2\n\ts_nop 0\n\tglobal_load_lds_dwordx4 %1, off\n\ts_mov_b32 m0, %0" : "=&s"(keep) : "v"(gsrc), "s"(lds_dst) : "memory"); }
__device__ __forceinline__ float max3f(float a, float b, float c) { float r; asm("v_max3_f32 %0, %1, %2, %3" : "=v"(r) : "v"(a), "v"(b), "v"(c)); return r; }
__device__ __forceinline__ float max2f(float a, float b) { float r; asm("v_max_f32_e32 %0, %1, %2" : "=v"(r) : "v"(a), "v"(b)); return r; }
__device__ __forceinline__ float fadd_s(float a, float b) { float r; asm("v_add_f32_e32 %0, %1, %2" : "=v"(r) : "v"(a), "v"(b)); return r; }
__device__ __forceinline__ float fsub_s(float a, float b) { float r; asm("v_sub_f32_e32 %0, %1, %2" : "=v"(r) : "v"(a), "v"(b)); return r; }
typedef float f32x2_t __attribute__((ext_vector_type(2))); typedef __bf16 bf16x2_t __attribute__((ext_vector_type(2)));
__device__ __forceinline__ unsigned cvtpk_s(float lo, float hi) { f32x2_t v = {lo, hi}; bf16x2_t b = __builtin_convertvector(v, bf16x2_t); return __builtin_bit_cast(unsigned, b); }
__device__ __forceinline__ float bflo(unsigned u) { return __uint_as_float(u << 16); }
__device__ __forceinline__ float bfhi(unsigned u) { return __uint_as_float(u & 0xffff0000u); }
#define WAIT_BAR(N) asm volatile("s_waitcnt vmcnt(" #N ") lgkmcnt(0)\n\ts_barrier" ::: "memory")

__device__ __forceinline__ void qkt(f32x16& p0, f32x16& p1, const char* Kslot, const bf16x8* qr, const f32x16& negm, int r32, int hi) {
    const char* kb = Kslot + hi * 1024 + r32 * 16;
#pragma unroll
    for (int d0 = 0; d0 < 4; ++d0) {
        const bf16x8 b0 = *reinterpret_cast<const bf16x8*>(kb + d0 * 2048);
        const bf16x8 b1 = *reinterpret_cast<const bf16x8*>(kb + d0 * 2048 + 512);
        if (d0 == 0) { p0 = __builtin_amdgcn_mfma_f32_32x32x16_bf16(b0, qr[0], negm, 0, 0, 0); p1 = __builtin_amdgcn_mfma_f32_32x32x16_bf16(b1, qr[0], negm, 0, 0, 0); }
        else { p0 = __builtin_amdgcn_mfma_f32_32x32x16_bf16(b0, qr[d0], p0, 0, 0, 0); p1 = __builtin_amdgcn_mfma_f32_32x32x16_bf16(b1, qr[d0], p1, 0, 0, 0); } }
}
__device__ __forceinline__ void qkt_acc(f32x16& p0, f32x16& p1, const char* Kslot, const bf16x8* qr, int r32, int hi) {
    const char* kb = Kslot + hi * 1024 + r32 * 16;
#pragma unroll
    for (int d0 = 0; d0 < 4; ++d0) {
        const bf16x8 b0 = *reinterpret_cast<const bf16x8*>(kb + d0 * 2048);
        const bf16x8 b1 = *reinterpret_cast<const bf16x8*>(kb + d0 * 2048 + 512);
        p0 = __builtin_amdgcn_mfma_f32_32x32x16_bf16(b0, qr[d0], p0, 0, 0, 0); p1 = __builtin_amdgcn_mfma_f32_32x32x16_bf16(b1, qr[d0], p1, 0, 0, 0); }
}
typedef __attribute__((address_space(3))) const char* lds_cptr;
typedef short v4i16_t __attribute__((ext_vector_type(4)));
__device__ __forceinline__ void kload8(bf16x8* kf, lds_cptr kp) {
    kf[0] = *(const LAS bf16x8*)(kp);        kf[1] = *(const LAS bf16x8*)(kp + 512);
    kf[2] = *(const LAS bf16x8*)(kp + 2048); kf[3] = *(const LAS bf16x8*)(kp + 2560);
    kf[4] = *(const LAS bf16x8*)(kp + 4096); kf[5] = *(const LAS bf16x8*)(kp + 4608);
    kf[6] = *(const LAS bf16x8*)(kp + 6144); kf[7] = *(const LAS bf16x8*)(kp + 6656);
}
__device__ __forceinline__ void kload2(bf16x8* kf, lds_cptr kp, int j) { kf[2 * j] = *(const LAS bf16x8*)(kp + j * 2048); kf[2 * j + 1] = *(const LAS bf16x8*)(kp + j * 2048 + 512); }
__device__ __forceinline__ s16x4 vtr(lds_cptr p) { return __builtin_bit_cast(s16x4, __builtin_amdgcn_ds_read_tr16_b64_v4i16((LAS v4i16_t*)p)); }
__device__ __forceinline__ float rowmax(const f32x16& p0, const f32x16& p1) {
    float a = max3f(p0[0], p0[1], p1[0]), b = max3f(p0[2], p0[3], p1[1]); a = max3f(a, p1[2], p1[3]);
#pragma unroll
    for (int r = 4; r < 16; r += 4) { a = max3f(a, p0[r], p0[r + 1]); b = max3f(b, p0[r + 2], p0[r + 3]); a = max3f(a, p1[r], p1[r + 1]); b = max3f(b, p1[r + 2], p1[r + 3]); }
    const float m = max2f(a, b);
    auto rr = __builtin_amdgcn_permlane32_swap(__float_as_uint(m), __float_as_uint(m), false, false);
    return max2f(__uint_as_float(rr[0]), __uint_as_float(rr[1]));
}
__device__ __forceinline__ void pv(f32x16* o, int vb, bf16x8 pa0, bf16x8 pa1, bf16x8 pa2, bf16x8 pa3) {
#pragma unroll
    for (int d0 = 0; d0 < 2; ++d0) { s16x4 lo[4], hi[4];
#pragma unroll
        for (int ks = 0; ks < 4; ++ks) {
            asm volatile("ds_read_b64_tr_b16 %0,%1 offset:%c2" : "=&v"(lo[ks]) : "v"(vb), "i"(d0 * 4096 + ks * 1024) : "memory");
            asm volatile("ds_read_b64_tr_b16 %0,%1 offset:%c2" : "=&v"(hi[ks]) : "v"(vb), "i"(d0 * 4096 + ks * 1024 + 512) : "memory"); }
        asm volatile("s_waitcnt lgkmcnt(0)" ::: "memory"); SBAR();
#define PK(k) (bf16x8){lo[k][0], lo[k][1], lo[k][2], lo[k][3], hi[k][0], hi[k][1], hi[k][2], hi[k][3]}
        o[d0] = __builtin_amdgcn_mfma_f32_32x32x16_bf16(pa0, PK(0), o[d0], 0, 0, 0);
        o[d0] = __builtin_amdgcn_mfma_f32_32x32x16_bf16(pa1, PK(1), o[d0], 0, 0, 0);
        o[d0] = __builtin_amdgcn_mfma_f32_32x32x16_bf16(pa2, PK(2), o[d0], 0, 0, 0);
        o[d0] = __builtin_amdgcn_mfma_f32_32x32x16_bf16(pa3, PK(3), o[d0], 0, 0, 0);
#undef PK
    }
}

enum { HK_REL = 0, HK_RELMASK = 1, HK_FOX = 2 };
constexpr float SM_REF = 6.0f;
struct UnitP {
    const bf16* Qp; const bf16* Kp; const bf16* Vp;
    long qrs, krs;
    int img;
    int q0, t_lo, NT;
    const float* tg; int W;
    int tfill, tCmax, tlen, tsh, toff;
    const float* cseq;
    const unsigned long long* mask64;
    const float* kmean; int qb;
    int mshift;
    bf16* Op; long ors;
    float* ml_out; long mls;
    const bf16* S1; const bf16* S2;
    const float* ml1; const float* ml2;
    const bf16* gate; long grs;
    int accum;
    int pre;
    const bf16* nQp; const bf16* nKp; const bf16* nVp; int nq0, ntlo, nNT;
};

template <int HOOK, int THRL, bool RES = false>
__device__ __forceinline__ void attn_unit(const UnitP& P, char* shm, const int wave_s, bf16x8 (&qr)[4], unsigned long long& mask) {
    constexpr int L_V = RES ? 6 * SLOTB : LDS_V, L_WS = RES ? 12 * SLOTB : LDS_WS, L_OST = L_WS + NW * 128 * 4, L_TAB = L_OST + NW * 4096, L_KM = RES ? L_TAB : LDS_KM;
    static_assert(!RES || (HOOK == HK_REL && L_TAB + 640 * 16 <= 147456 - 64), "resident-tile LDS map");
    int wid_l = wave_s; asm volatile("" : "+s"(wid_l));
    const int lane = lane_id_v(), wid = wid_l, tid = wid * 64 + lane, r32 = lane & 31, hi = lane >> 5;
    const int NT = P.NT;
    constexpr bool USE_NEGM = false; constexpr bool ONLINE = false;
    const bf16* Qw = P.Qp + (long)(P.q0 + wid * QBLK) * P.qrs;
    const unsigned lds0 = (unsigned)(uintptr_t)shm;
    LAS float* wsf = (LAS float*)((LAS char*)(uintptr_t)lds0 + L_WS) + wid * 128;
    LAS float* tabL = (LAS float*)((LAS char*)(uintptr_t)lds0 + L_TAB);
    LAS float* kmL = (LAS float*)((LAS char*)(uintptr_t)lds0 + L_KM);
    const long tstride = P.img ? 4096L : (long)KVBLK * P.krs;
    const int kswz_ = ((lane >> 3) ^ ((wid >> 1) & 1)) & 7;
    const bf16* ksrc = RES ? (P.Kp + ((long)P.t_lo * KVBLK + 8 * wid + (lane >> 3)) * P.krs + ((lane & 7) ^ kswz_) * 8)
                     : (P.img ? (P.Kp + (long)P.t_lo * 4096 + wid * 512 + lane * 8) : (P.Kp + ((long)P.t_lo * KVBLK + lane) * P.krs + wid * 8));
    const bf16* vsrc = P.img ? (P.Vp + (long)P.t_lo * 4096 + wid * 512 + lane * 8) : (P.Vp + ((long)P.t_lo * KVBLK + 16 * (wid & 3) + (lane >> 2)) * P.krs + (wid >> 2) * 32 + (lane & 3) * 8);
    const unsigned kdst = lds0 + LDS_K + wid * 1024, vdst = lds0 + L_V + wid * 1024;
#define DMA_K(t, slot) glds16(ksrc + (long)(t) * tstride, (unsigned)__builtin_amdgcn_readfirstlane(kdst + (slot)))
#define DMA_V(t, slot) glds16(vsrc + (long)(t) * tstride, (unsigned)__builtin_amdgcn_readfirstlane(vdst + (slot)))
    const int qrel = wid * QBLK + r32;
    const int vb0 = (int)(lds0 + L_V) + ((lane >> 4) & 1) * 32 + (lane & 3) * 8 + (4 * hi + ((lane & 15) >> 2)) * 64;
    const char* Kbase = shm + LDS_K; bf16x8 kf[8];
    int kof[4];
    { const int kk_ = r32 & 7, g_ = kk_ ^ ((r32 >> 4) & 1);
      _Pragma("unroll") for (int d0 = 0; d0 < 4; ++d0) kof[d0] = (r32 >> 3) * 1024 + kk_ * 128 + (((2 * d0 + hi) ^ g_) & 7) * 16; }
#define KLD_RES(dst, slot, j) do { dst[2 * (j)] = *(const LAS bf16x8*)(shm3 + LDS_K + (slot) + kof[j]); dst[2 * (j) + 1] = *(const LAS bf16x8*)(shm3 + LDS_K + (slot) + kof[j] + 4096); } while (0)
    const lds_cptr shm3 = (lds_cptr)(uintptr_t)lds0; const lds_cptr kp0 = shm3 + LDS_K + hi * 1024 + r32 * 16; const lds_cptr vp0 = shm3 + L_V + ((lane >> 4) & 1) * 32 + (lane & 3) * 8 + (4 * hi + ((lane & 15) >> 2)) * 64;
    if (!P.pre) {
    if (RES) {
#pragma unroll 1
        for (int t_ = 0; t_ < NT; ++t_) { DMA_K(t_, t_ * SLOTB); DMA_V(t_, t_ * SLOTB); }
    } else { DMA_K(0, 0); DMA_V(0, 0); DMA_K(1, SLOTB); }
#pragma unroll
    for (int d0 = 0; d0 < 4; ++d0) qr[d0] = *reinterpret_cast<const bf16x8*>(&Qw[(long)r32 * P.qrs + d0 * 16 + hi * 8]);
    }
    float mhat = 0.f, l_reg = 0.f; const float zf_ = opaque_zero(); f32x16 o[2]; f32x16 negm = f32x16{}; _Pragma("unroll") for (int r = 0; r < 16; ++r) { o[0][r] = zf_; o[1][r] = zf_; if (USE_NEGM) negm[r] = zf_; } if (USE_NEGM) asm volatile("" : "+v"(negm));
#define CINIT (USE_NEGM ? negm : f32x16{})
#define BIASLD(C0, C1, t) do { \
    if (HOOK == HK_FOX) { const LAS f32x4* cb_ = (const LAS f32x4*)tabL + (16 * (t) + hi); \
        _Pragma("unroll") for (int g_ = 0; g_ < 4; ++g_) { const f32x4 a_ = cb_[2 * g_], b_ = cb_[8 + 2 * g_]; \
            C0[4 * g_] = a_[0]; C0[4 * g_ + 1] = a_[1]; C0[4 * g_ + 2] = a_[2]; C0[4 * g_ + 3] = a_[3]; \
            C1[4 * g_] = b_[0]; C1[4 * g_ + 1] = b_[1]; C1[4 * g_ + 2] = b_[2]; C1[4 * g_ + 3] = b_[3]; } } \
    else { int j0_ = 64 * (t) + 4 * hi - qrel + 255 + P.tsh - P.toff; j0_ = j0_ < 0 ? 0 : j0_;     \
        if (HOOK == HK_RELMASK) { if (!((mask >> (((t) + P.t_lo) >> P.mshift)) & 1ull)) j0_ = P.tlen - 64; }     \
        const LAS f32x4* tb4_ = (const LAS f32x4*)tabL + j0_; \
        _Pragma("unroll") for (int g_ = 0; g_ < 4; ++g_) { const f32x4 a_ = tb4_[8 * g_], b_ = tb4_[32 + 8 * g_]; \
            C0[4 * g_] = a_[0]; C0[4 * g_ + 1] = a_[1]; C0[4 * g_ + 2] = a_[2]; C0[4 * g_ + 3] = a_[3]; \
            C1[4 * g_] = b_[0]; C1[4 * g_ + 1] = b_[1]; C1[4 * g_ + 2] = b_[2]; C1[4 * g_ + 3] = b_[3]; } } \
    } while (0)
#define POSTF(C0, C1, t) do { \
    if (HOOK == HK_FOX) { _Pragma("unroll") for (int r = 0; r < 16; ++r) { C0[r] = fadd_s(C0[r], ctn); C1[r] = fadd_s(C1[r], ctn); }     \
        const int jb_ = (t) - (NT - 4); if (jb_ >= 0) cmask(C0, C1, jb_, qrel, hi); } \
    } while (0)
    bool resc = false;
#define START(P0, P1) do { resc = false; \
    if (ONLINE) { const float rm = rowmax(P0, P1); const float dl = __builtin_fmaxf(rm, floorv); mhat = fadd_s(mhat, dl); \
      _Pragma("unroll") for (int r = 0; r < 16; ++r) { P0[r] = fsub_s(P0[r], dl); P1[r] = fsub_s(P1[r], dl); } \
      if (USE_NEGM) { _Pragma("unroll") for (int r = 0; r < 16; ++r) negm[r] = -mhat; asm volatile("" : "+v"(negm)); } } \
    _Pragma("unroll") for (int r = 0; r < 16; ++r) P0[r] = __builtin_amdgcn_exp2f(P0[r]); } while (0)
#define RESC() do { if (resc) { asm volatile("s_waitcnt lgkmcnt(0)" ::: "memory"); \
      _Pragma("unroll") for (int d_ = 0; d_ < 2; ++d_) _Pragma("unroll") for (int r = 0; r < 16; ++r) o[d_][r] *= wsf[crow(r, hi)]; } } while (0)
    f32x16 pA0, pA1, pB0, pB1;
    int sl_prev = 0, sl_cur = 0, sl_next = SLOTB;
#define ROT() do { sl_prev = sl_cur; sl_cur = sl_next; sl_next = (sl_next == (NSLOT - 1) * SLOTB) ? 0 : sl_next + SLOTB; } while (0)
    if (!RES && !P.pre) { DMA_K(2, 2 * SLOTB); DMA_V(1, SLOTB); }
    float floorv = -30.f, ctn = 0.f; (void)floorv;
    if (HOOK != HK_FOX) {
        if (P.tfill) {
            const int n = P.tlen, dbase = P.tCmax + 255 - P.toff;
            for (int j = tid; j < n; j += NW * 64) { f32x4 v;
#pragma unroll
                for (int k = 0; k < 4; ++k) { const int d = dbase - j - k; float x = -INFINITY; if (d >= 0 && d <= P.W) x = P.tg[d] - SM_REF; v[k] = x; }
                ((LAS f32x4*)tabL)[j] = v; }
            if (HOOK == HK_RELMASK && P.kmean) {
                LAS bf16* kmh_ = (LAS bf16*)kmL; LAS bf16* kml_ = kmh_ + 2048;
                for (int j = tid; j < 1024; j += NW * 64) { const int n_ = j >> 6, d_ = j & 63; const float v_ = P.kmean[j];
                    const unsigned hb_ = __float_as_uint(v_) >> 16; const float vh_ = __uint_as_float(hb_ << 16);
                    const unsigned lb_ = cvtpk_s(v_ - vh_, 0.f) & 0xffffu;
                    const int e_ = (d_ >> 3) * 256 + n_ * 8 + (d_ & 7);
                    kmh_[e_] = (bf16)hb_; kml_[e_] = (bf16)lb_; kmh_[e_ + 128] = 0; kml_[e_ + 128] = 0; } }
        }
    } else {
        if (P.tfill) {
            const f32x4 u0 = *(const f32x4*)(P.cseq + 8 * tid), u1 = *(const f32x4*)(P.cseq + 8 * tid + 4);
            float pf[8]; pf[0] = u0[0]; pf[1] = pf[0] + u0[1]; pf[2] = pf[1] + u0[2]; pf[3] = pf[2] + u0[3]; pf[4] = pf[3] + u1[0]; pf[5] = pf[4] + u1[1]; pf[6] = pf[5] + u1[2]; pf[7] = pf[6] + u1[3];
            float incl = pf[7];
#pragma unroll
            for (int o_ = 1; o_ < 64; o_ <<= 1) { const float up_ = __int_as_float(__builtin_amdgcn_ds_bpermute((lane - o_) << 2, __float_as_int(incl))); if (lane >= o_) incl += up_; }
            if (lane == 63) kmL[wid] = incl;
            asm volatile("s_waitcnt lgkmcnt(0)\n\ts_barrier" ::: "memory");
            float off_ = incl - pf[7];
#pragma unroll
            for (int w_ = 0; w_ < NW - 1; ++w_) off_ += (w_ < wid) ? kmL[w_] : 0.f;
#pragma unroll
            for (int i_ = 0; i_ < 8; ++i_) tabL[8 * tid + i_] = -(off_ + pf[i_]) * LOG2E;
        }
    }
    if (!P.pre) { mask = ~0ull; if (HOOK == HK_RELMASK && P.mask64) mask = P.mask64[P.q0 + qrel]; }
    if (USE_NEGM) { _Pragma("unroll") for (int r = 0; r < 16; ++r) negm[r] = ctn; asm volatile("" : "+v"(negm)); }
    int ta = 0;
    if (RES) {
        if (P.pre) asm volatile("s_waitcnt vmcnt(8) lgkmcnt(0)\n\ts_barrier" ::: "memory"); else asm volatile("s_waitcnt vmcnt(0) lgkmcnt(0)\n\ts_barrier" ::: "memory");
        const int tb_ = ((P.q0 + wid * QBLK + 31) >> 6) - P.t_lo; ta = tb_ - 2; ta = ta < 0 ? 0 : ta;
    } else if (P.pre) { WAIT_BAR(8); }
    else
    WAIT_BAR(3);
    if (HOOK == HK_FOX) ctn = -tabL[P.q0 + qrel] - SM_REF;
    if (HOOK == HK_RELMASK && P.kmean) {
        const int qb = P.qb;
        f32x16 gs_; { const float z_ = opaque_zero(); _Pragma("unroll") for (int r = 0; r < 16; ++r) gs_[r] = z_; }
        { const LAS char* kb_ = (const LAS char*)kmL + hi * 512 + r32 * 16;
#pragma unroll
          for (int d0 = 0; d0 < 4; ++d0) { const bf16x8 ah_ = *(const LAS bf16x8*)(kb_ + d0 * 1024), al_ = *(const LAS bf16x8*)(kb_ + 4096 + d0 * 1024);
              gs_ = __builtin_amdgcn_mfma_f32_32x32x16_bf16(ah_, qr[d0], gs_, 0, 0, 0); gs_ = __builtin_amdgcn_mfma_f32_32x32x16_bf16(al_, qr[d0], gs_, 0, 0, 0); } }
        float sc_[16];
#pragma unroll
        for (int r = 0; r < 8; ++r) { auto rr = __builtin_amdgcn_permlane32_swap(__float_as_uint(gs_[r]), __float_as_uint(gs_[r]), false, false);
            const int n0_ = (r & 3) + 8 * (r >> 2); sc_[n0_] = __uint_as_float(rr[0]); sc_[n0_ + 4] = __uint_as_float(rr[1]); }
        float v1 = -INFINITY, v2 = -INFINITY, v3 = -INFINITY; int i1 = 31, i2 = 31, i3 = 31;
#pragma unroll
        for (int n = 0; n < 15; ++n) { if (n < qb) { const float s = sc_[n];
            if (s > v1) { v3 = v2; i3 = i2; v2 = v1; i2 = i1; v1 = s; i1 = n; } else if (s > v2) { v3 = v2; i3 = i2; v2 = s; i2 = n; } else if (s > v3) { v3 = s; i3 = n; } } }
        unsigned mk = (1u << qb) | ((1u << i1) | (1u << i2) | (1u << i3));
        mk &= 0xffffu;
        mask = (unsigned long long)mk;
    }
    BIASLD(pA0, pA1, ta);
    if (RES) { _Pragma("unroll") for (int j = 0; j < 4; ++j) KLD_RES(kf, ta * SLOTB, j);
        _Pragma("unroll") for (int d0 = 0; d0 < 4; ++d0) { pA0 = __builtin_amdgcn_mfma_f32_32x32x16_bf16(kf[2 * d0], qr[d0], pA0, 0, 0, 0); pA1 = __builtin_amdgcn_mfma_f32_32x32x16_bf16(kf[2 * d0 + 1], qr[d0], pA1, 0, 0, 0); } }
    else qkt_acc(pA0, pA1, Kbase, qr, r32, hi);
    asm volatile("s_nop 15\n\ts_nop 7" : "+v"(pA0), "+v"(pA1)); POSTF(pA0, pA1, 0);
    START(pA0, pA1);
    _Pragma("unroll") for (int r = 0; r < 16; ++r) pA1[r] = __builtin_amdgcn_exp2f(pA1[r]);
    if (RES) { sl_prev = ta * SLOTB; sl_cur = sl_prev + SLOTB; sl_next = sl_cur + SLOTB; _Pragma("unroll") for (int j = 0; j < 4; ++j) KLD_RES(kf, sl_cur, j); asm volatile("s_waitcnt lgkmcnt(0)" ::: "memory"); }
    else {
    if (P.pre) { WAIT_BAR(8); } else
    WAIT_BAR(0);
    DMA_K(3, 0);
    ROT();
    kload8(kf, kp0 + sl_cur);
    WAIT_BAR(2);
    }
    s16x4 vlo[8], vhi[8]; u32x4 pw0, pw1, pw2, pw3;
#define PKW(P, B) cvtpk_s(P[B], P[B + 1])
#define PAF(k) __builtin_bit_cast(bf16x8, pw##k)
#define VFR(i) (bf16x8){vlo[i][0], vlo[i][1], vlo[i][2], vlo[i][3], vhi[i][0], vhi[i][1], vhi[i][2], vhi[i][3]}
#define PIN(x) asm volatile("" : "+v"(x))
#define MX3(a, b, c) __builtin_fmaxf(__builtin_fmaxf((a), (b)), (c))
#define GAPA(MF, A0, A1, A2, A3, W0, W1, PW) do { MF; sacc += A0; sacc += A1; sacc += A2; sacc += A3; PIN(sacc); W0; W1; PIN(PW); SBAR(); } while (0)
#define EX(v) __builtin_amdgcn_exp2f(v)
#define GAPB(MF, X, B) do { MF; PIN(o[0]); PIN(o[1]);     \
    X[B] = EX(X[B]); X[B + 1] = EX(X[B + 1]); X[B + 2] = EX(X[B + 2]); X[B + 3] = EX(X[B + 3]); PIN(X); SBAR(); } while (0)
#define VRD(i) do { vlo[i] = vtr(vp_ + (((i) >> 2) * 4096 + ((i) & 3) * 1024)); vhi[i] = vtr(vp_ + (((i) >> 2) * 4096 + ((i) & 3) * 1024 + 512)); } while (0)
#define KRD(G, j) do { if (G) { if (RES) KLD_RES(kf, sl_next, j); else kload2(kf, kp0 + sl_next, j); SBAR(); } } while (0)
#define STEP(C0, C1, P0, P1, t, GK, GV, GL) do { SBAR(); \
    BIASLD(C0, C1, t); SBAR(); \
    const lds_cptr vp_ = vp0 + sl_prev; \
    VRD(0); SBAR(); float sacc = (P0[0] + P0[1]); \
    GAPA(C0 = __builtin_amdgcn_mfma_f32_32x32x16_bf16(kf[0], qr[0], C0, 0, 0, 0), P0[2], P0[3], P0[4], P0[5],     pw0[0] = PKW(P0, 0), pw0[1] = PKW(P0, 2), pw0); \
    VRD(4); SBAR(); GAPA(C1 = __builtin_amdgcn_mfma_f32_32x32x16_bf16(kf[1], qr[0], C1, 0, 0, 0), P0[6], P0[7], P0[8], P0[9],     pw0[2] = PKW(P0, 4), pw0[3] = PKW(P0, 6), pw0); \
    VRD(1); SBAR(); GAPA(C0 = __builtin_amdgcn_mfma_f32_32x32x16_bf16(kf[2], qr[1], C0, 0, 0, 0),   P0[10], P0[11], P0[12], P0[13], pw1[0] = PKW(P0, 8), pw1[1] = PKW(P0, 10), pw1); \
    VRD(5); SBAR(); GAPA(C1 = __builtin_amdgcn_mfma_f32_32x32x16_bf16(kf[3], qr[1], C1, 0, 0, 0),   P0[14], P0[15], P1[0], P1[1],   pw1[2] = PKW(P0, 12), pw1[3] = PKW(P0, 14), pw1); \
    VRD(2); SBAR(); GAPA(C0 = __builtin_amdgcn_mfma_f32_32x32x16_bf16(kf[4], qr[2], C0, 0, 0, 0),   P1[2], P1[3], P1[4], P1[5],     pw2[0] = PKW(P1, 0), pw2[1] = PKW(P1, 2), pw2); \
    VRD(6); SBAR(); GAPA(C1 = __builtin_amdgcn_mfma_f32_32x32x16_bf16(kf[5], qr[2], C1, 0, 0, 0),   P1[6], P1[7], P1[8], P1[9],     pw2[2] = PKW(P1, 4), pw2[3] = PKW(P1, 6), pw2); \
    VRD(3); SBAR(); GAPA(C0 = __builtin_amdgcn_mfma_f32_32x32x16_bf16(kf[6], qr[3], C0, 0, 0, 0),   P1[10], P1[11], P1[12], P1[13], pw3[0] = PKW(P1, 8), pw3[1] = PKW(P1, 10), pw3); \
    VRD(7); SBAR(); GAPA(C1 = __builtin_amdgcn_mfma_f32_32x32x16_bf16(kf[7], qr[3], C1, 0, 0, 0),   P1[14], P1[15], 0.f, 0.f,       pw3[2] = PKW(P1, 12), pw3[3] = PKW(P1, 14), pw3); \
    l_reg += sacc; \
    if (GK) { DMA_K((t) + 3, sl_cur); } if (GV) { DMA_V((t) + 1, sl_next); } \
    POSTF(C0, C1, t); \
    if (ONLINE) { float a = MX3(C0[0], C0[1], C1[0]), b = MX3(C0[2], C0[3], C1[1]); a = MX3(a, C1[2], C1[3]); \
      _Pragma("unroll") for (int r = 4; r < 16; r += 4) { a = MX3(a, C0[r], C0[r + 1]); b = MX3(b, C0[r + 2], C0[r + 3]); a = MX3(a, C1[r], C1[r + 1]); b = MX3(b, C1[r + 2], C1[r + 3]); } \
      float rm = __builtin_fmaxf(a, b); { auto rr = __builtin_amdgcn_permlane32_swap(__float_as_uint(rm), __float_as_uint(rm), false, false); rm = __builtin_fmaxf(__uint_as_float(rr[0]), __uint_as_float(rr[1])); } \
      resc = false; \
      if (__builtin_expect(__any(rm > (float)THRL), 0)) { const float dl = __builtin_fmaxf(rm, 0.f); mhat += dl; \
        _Pragma("unroll") for (int r = 0; r < 16; ++r) { C0[r] -= dl; C1[r] -= dl; } \
        if (USE_NEGM) { _Pragma("unroll") for (int r = 0; r < 16; ++r) negm[r] = -mhat; asm volatile("" : "+v"(negm)); } \
        const float f = __builtin_amdgcn_exp2f(-dl); l_reg *= f; if (hi == 0) wsf[r32] = f; resc = true; } } \
    SBAR(); \
    GAPB(o[0] = __builtin_amdgcn_mfma_f32_32x32x16_bf16(PAF(0), VFR(0), o[0], 0, 0, 0), C0, 0); \
    GAPB(o[1] = __builtin_amdgcn_mfma_f32_32x32x16_bf16(PAF(0), VFR(4), o[1], 0, 0, 0), C0, 4); \
    KRD(GL, 0); GAPB(o[0] = __builtin_amdgcn_mfma_f32_32x32x16_bf16(PAF(1), VFR(1), o[0], 0, 0, 0), C0, 8); \
    KRD(GL, 1); GAPB(o[1] = __builtin_amdgcn_mfma_f32_32x32x16_bf16(PAF(1), VFR(5), o[1], 0, 0, 0), C0, 12); \
    KRD(GL, 2); GAPB(o[0] = __builtin_amdgcn_mfma_f32_32x32x16_bf16(PAF(2), VFR(2), o[0], 0, 0, 0), C1, 0); \
    KRD(GL, 3); GAPB(o[1] = __builtin_amdgcn_mfma_f32_32x32x16_bf16(PAF(2), VFR(6), o[1], 0, 0, 0), C1, 4); \
    GAPB(o[0] = __builtin_amdgcn_mfma_f32_32x32x16_bf16(PAF(3), VFR(3), o[0], 0, 0, 0), C1, 8); \
    GAPB(o[1] = __builtin_amdgcn_mfma_f32_32x32x16_bf16(PAF(3), VFR(7), o[1], 0, 0, 0), C1, 12); \
    } while (0)
#define DRAIN(X0, X1) do { float sacc = X0[0] + X0[1]; _Pragma("unroll") for (int r = 2; r < 16; ++r) sacc += X0[r]; _Pragma("unroll") for (int r = 0; r < 16; ++r) sacc += X1[r]; l_reg += sacc; \
      pw0 = (u32x4){PKW(X0, 0), PKW(X0, 2), PKW(X0, 4), PKW(X0, 6)}; pw1 = (u32x4){PKW(X0, 8), PKW(X0, 10), PKW(X0, 12), PKW(X0, 14)}; pw2 = (u32x4){PKW(X1, 0), PKW(X1, 2), PKW(X1, 4), PKW(X1, 6)}; pw3 = (u32x4){PKW(X1, 8), PKW(X1, 10), PKW(X1, 12), PKW(X1, 14)}; \
      SBAR(); pv(o, vb0 + sl_cur, PAF(0), PAF(1), PAF(2), PAF(3)); } while (0)
    if (RES) {
        STEP(pB0, pB1, pA0, pA1, ta + 1, false, false, true); asm volatile("s_waitcnt lgkmcnt(0)" ::: "memory");
        sl_prev = sl_cur; sl_cur = sl_next;
        STEP(pA0, pA1, pB0, pB1, ta + 2, false, false, false);
        DRAIN(pA0, pA1);
    } else {
    const int NTw = (wid < 4) ? NT - 2 : NT;
    int t = 1;
    for (; t + 5 < NTw; t += 2) {
        STEP(pB0, pB1, pA0, pA1, t, true, true, true);     WAIT_BAR(2); RESC(); ROT();
        STEP(pA0, pA1, pB0, pB1, t + 1, true, true, true); WAIT_BAR(2); RESC(); ROT();
    }
#define ENDW(tt) do { if ((tt) + 3 < NT) { WAIT_BAR(2); } else if ((tt) + 2 < NT) { WAIT_BAR(1); } else { WAIT_BAR(0); } } while (0)
    for (; t + 1 < NTw; t += 2) {
        STEP(pB0, pB1, pA0, pA1, t, (t + 3 < NT), (t + 1 < NT), (t + 1 < NTw));       ENDW(t);     RESC(); ROT();
        STEP(pA0, pA1, pB0, pB1, t + 1, (t + 4 < NT), (t + 2 < NT), (t + 2 < NTw));   ENDW(t + 1); RESC(); ROT();
    }
    STEP(pB0, pB1, pA0, pA1, NTw - 1, false, (NTw < NT), false); RESC();
    if (NTw < NT) { ENDW(NTw - 1); }
    DRAIN(pB0, pB1);
    if (NTw < NT) { ROT(); DMA_V(NT - 1, sl_next); WAIT_BAR(0); }
    }
    float e_m1 = 0.f, e_l1 = 0.f, e_m2 = 0.f, e_l2 = 0.f; unsigned e_gate = 0u; u32x4 e_s1[4], e_s2[4];
    { const long qrow_ = P.q0 + qrel;
      if (P.ml1) { e_m1 = P.ml1[qrow_ * P.mls]; e_l1 = P.ml1[qrow_ * P.mls + 1]; e_m2 = P.ml2[qrow_ * P.mls]; e_l2 = P.ml2[qrow_ * P.mls + 1]; }
      else if (P.gate) e_gate = (unsigned)P.gate[qrow_ * P.grs];
      if (P.S1) {
#pragma unroll
          for (int i = 0; i < 4; ++i) { const long goff_ = ((long)(P.q0 + wid * QBLK) + i * 8 + (lane >> 3)) * P.ors + (lane & 7) * 8; e_s1[i] = *(const u32x4*)(P.S1 + goff_); if (P.S2) e_s2[i] = *(const u32x4*)(P.S2 + goff_); } } }
    if (P.nQp) {
        asm volatile("s_barrier" ::: "memory");
        const bf16* nk = RES ? (P.nKp + ((long)P.ntlo * KVBLK + 8 * wid + (lane >> 3)) * P.krs + ((lane & 7) ^ kswz_) * 8)
                       : (P.img ? (P.nKp + (long)P.ntlo * 4096 + wid * 512 + lane * 8) : (P.nKp + ((long)P.ntlo * KVBLK + lane) * P.krs + wid * 8));
        const bf16* nv = P.img ? (P.nVp + (long)P.ntlo * 4096 + wid * 512 + lane * 8) : (P.nVp + ((long)P.ntlo * KVBLK + 16 * (wid & 3) + (lane >> 2)) * P.krs + (wid >> 2) * 32 + (lane & 3) * 8);
        if (RES) {
#pragma unroll 1
            for (int t_ = 0; t_ < P.nNT; ++t_) { glds16(nk + t_ * tstride, (unsigned)__builtin_amdgcn_readfirstlane(kdst + t_ * SLOTB)); glds16(nv + t_ * tstride, (unsigned)__builtin_amdgcn_readfirstlane(vdst + t_ * SLOTB)); }
        } else {
        glds16(nk, (unsigned)__builtin_amdgcn_readfirstlane(kdst)); glds16(nv, (unsigned)__builtin_amdgcn_readfirstlane(vdst));
        glds16(nk + tstride, (unsigned)__builtin_amdgcn_readfirstlane(kdst + SLOTB)); glds16(nk + 2 * tstride, (unsigned)__builtin_amdgcn_readfirstlane(kdst + 2 * SLOTB));
        glds16(nv + tstride, (unsigned)__builtin_amdgcn_readfirstlane(vdst + SLOTB));
        }
        const bf16* nQw = P.nQp + (long)(P.nq0 + wid * QBLK) * P.qrs;
#pragma unroll
        for (int d0 = 0; d0 < 4; ++d0) qr[d0] = *reinterpret_cast<const bf16x8*>(&nQw[(long)r32 * P.qrs + d0 * 16 + hi * 8]);
        if (HOOK == HK_RELMASK && P.mask64) mask = P.mask64[P.nq0 + qrel];
    }
#undef PKW
#undef PAF
#undef VFR
#undef PIN
#undef MX3
#undef GAPA
#undef GAPB
#undef EX
#undef VRD
#undef KRD
#undef KLD_RES
#undef STEP
#undef ENDW
#undef DRAIN
    { auto rr = __builtin_amdgcn_permlane32_swap(__float_as_uint(l_reg), __float_as_uint(l_reg), false, false); l_reg = __uint_as_float(rr[0]) + __uint_as_float(rr[1]); }
    {
        const long qrow = P.q0 + qrel;
        float sc, a1 = 0.f, a2 = 0.f;
        if (P.ml1) {
            const float m1 = e_m1, l1 = e_l1, m2 = e_m2, l2 = e_l2;
            const float Mx = fmaxf(fmaxf(m1, m2), mhat);
            const float e1 = __builtin_amdgcn_exp2f(m1 - Mx), e2 = __builtin_amdgcn_exp2f(m2 - Mx), e3 = __builtin_amdgcn_exp2f(mhat - Mx);
            const float w1 = l1 * e1, w2 = l2 * e2, w3 = l_reg * e3; const float iw = 1.0f / fmaxf((w1 + w2) + w3, 1e-30f);
            sc = e3 * iw; a1 = w1 * iw; a2 = w2 * iw;
        } else {
            sc = 1.0f / fmaxf(l_reg, 1e-30f);
            if (P.gate) { const float gl = bflo(e_gate); sc *= 1.0f / (1.0f + __expf(-gl)); }
            a1 = P.accum ? 1.f : 0.f;
        }
        if (P.ml_out && hi == 0) { P.ml_out[qrow * P.mls] = mhat; P.ml_out[qrow * P.mls + 1] = l_reg; }
        if (hi == 0) { wsf[32 + r32] = sc; wsf[64 + r32] = a1; wsf[96 + r32] = a2; }
    }
    asm volatile("s_waitcnt lgkmcnt(0)" ::: "memory");
    float rli[16];
#pragma unroll
    for (int r = 0; r < 16; ++r) rli[r] = wsf[32 + crow(r, hi)];
    {
        LAS bf16* stg = (LAS bf16*)((LAS char*)(uintptr_t)lds0 + L_OST) + wid * 2048;
#pragma unroll
        for (int r = 0; r < 16; r += 1) { const int orow = crow(r, hi);
#pragma unroll
            for (int d0 = 0; d0 < 2; ++d0) { const unsigned pk = cvtpk_s(o[d0][r] * rli[r], 0.f); stg[orow * 64 + d0 * 32 + r32] = (bf16)(pk & 0xffffu); } }
        asm volatile("s_waitcnt lgkmcnt(0)" ::: "memory");
        const long obase = (long)(P.q0 + wid * QBLK);
#pragma unroll
        for (int i = 0; i < 4; ++i) { const int row = i * 8 + (lane >> 3), ch = lane & 7; u32x4 v = *(const LAS u32x4*)(stg + row * 64 + ch * 8);
            const long goff = (obase + row) * P.ors + ch * 8;
            if (P.S1) { const float c1 = wsf[64 + row]; const u32x4 s = e_s1[i];
                float f[8];
#pragma unroll
                for (int k = 0; k < 4; ++k) { f[2 * k] = bflo(v[k]) + c1 * bflo(s[k]); f[2 * k + 1] = bfhi(v[k]) + c1 * bfhi(s[k]); }
                if (P.S2) { const float c2 = wsf[96 + row]; const u32x4 s2 = e_s2[i];
#pragma unroll
                    for (int k = 0; k < 4; ++k) { f[2 * k] += c2 * bflo(s2[k]); f[2 * k + 1] += c2 * bfhi(s2[k]); } }
#pragma unroll
                for (int k = 0; k < 4; ++k) v[k] = cvtpk_s(f[2 * k], f[2 * k + 1]); }
            *(u32x4*)(P.Op + goff) = v; }
    }
    if (!P.nQp) asm volatile("s_waitcnt lgkmcnt(0)\n\ts_barrier" ::: "memory");
#undef DMA_K
#undef DMA_V
#undef BIASLD
#undef POSTF
#undef CINIT
#undef START
#undef RESC
#undef ROT
}
#undef WAIT_BAR
}

typedef unsigned short bf16;
typedef unsigned v4u __attribute__((ext_vector_type(4)));
typedef float f32x4 __attribute__((ext_vector_type(4)));
#define LDS_WAIT() asm volatile("s_waitcnt lgkmcnt(0)" ::: "memory")
__device__ __forceinline__ unsigned f2bf(float f) { unsigned u = __builtin_bit_cast(unsigned, f); return (u + 0x7fffu + ((u >> 16) & 1u)) >> 16; }
__device__ __forceinline__ unsigned pk2(float lo, float hi) { return f2bf(lo) | (f2bf(hi) << 16); }
__device__ __forceinline__ float wave_sum(float v, int lane) {
#pragma unroll
    for (int o = 1; o < 64; o <<= 1) v += shx(v, o, lane);
    return v;
}
__device__ __forceinline__ int rel_bucket(int d) {
    if (d < 16) return d;
    const float v = logf((float)d / 16.0f) / 4.852030263919617f * 16.0f;
    const int b = 16 + (int)v; return b < 31 ? b : 31;
}
__device__ __forceinline__ int rel_bucket_fast(int d) {
    const float v = (__builtin_amdgcn_logf((float)d) - 4.0f) * (16.0f / 7.0f);
    int b = 16 + (int)v; b = b < 31 ? b : 31; return d < 16 ? d : b;
}
__device__ __forceinline__ void wt_load(const float* W, int ldw, int N, int nblk, int item, int lane, float (&wv)[32]) {
    const int kb = item / nblk, nb = item % nblk, k0 = 64 * kb, n0 = 32 * nb;
    const int nn = n0 + (lane & 31); const bool ok = nn < N;
#pragma unroll
    for (int i = 0; i < 32; ++i) { const int kk = 2 * i + (lane >> 5); wv[i] = ok ? W[(size_t)(k0 + kk) * ldw + nn] : 0.f; }
}
__device__ __forceinline__ void wt_store(int K, int nblk, bf16* WT, const float* gs, bool headperm, LAS float* scr, int item, int lane, const float (&wv)[32]) {
    const int kb = item / nblk, nb = item % nblk, k0 = 64 * kb, n0 = 32 * nb;
#pragma unroll
    for (int i = 0; i < 32; ++i) { const int kk = 2 * i + (lane >> 5); float v = wv[i]; if (gs) v *= gs[k0 + kk]; scr[kk * 33 + (lane & 31)] = v; }
    LDS_WAIT(); asm volatile("" ::: "memory");
    const int c = lane & 7;
    const int r0 = headperm ? (256 * (n0 / 256) + 128 * ((n0 % 64) / 32) + 32 * ((n0 % 256) / 64)) : n0;
#pragma unroll
    for (int j = 0; j < 4; ++j) { const int n = (lane >> 3) + 8 * j; const LAS float* s = scr + (8 * c) * 33 + n;
        v4u o; o.x = pk2(s[0 * 33], s[1 * 33]); o.y = pk2(s[2 * 33], s[3 * 33]); o.z = pk2(s[4 * 33], s[5 * 33]); o.w = pk2(s[6 * 33], s[7 * 33]);
        { const int row_ = r0 + n, kk_ = k0 + 8 * c; *(v4u*)(WT + ((size_t)((row_ >> 4) * (K / 32) + (kk_ >> 5)) * 512 + (row_ & 15) * 32 + (kk_ & 31))) = o; } }
    LDS_WAIT(); asm volatile("" ::: "memory");
}
__device__ __forceinline__ void wt_item(const float* W, int ldw, int N, int K, int nblk, bf16* WT, const float* gs, bool headperm, LAS float* scr, int item, int lane) {
    const int kb = item / nblk, nb = item % nblk, k0 = 64 * kb, n0 = 32 * nb;
    const int nn = n0 + (lane & 31); const bool ok = nn < N;
    float wv[32];
#pragma unroll
    for (int i = 0; i < 32; ++i) { const int kk = 2 * i + (lane >> 5); wv[i] = ok ? W[(size_t)(k0 + kk) * ldw + nn] : 0.f; }
#pragma unroll
    for (int i = 0; i < 32; ++i) { const int kk = 2 * i + (lane >> 5); float v = wv[i]; if (gs) v *= gs[k0 + kk]; scr[kk * 33 + (lane & 31)] = v; }
    LDS_WAIT(); asm volatile("" ::: "memory");
    const int c = lane & 7;
    const int r0 = headperm ? (256 * (n0 / 256) + 128 * ((n0 % 64) / 32) + 32 * ((n0 % 256) / 64)) : n0;
#pragma unroll
    for (int j = 0; j < 4; ++j) { const int n = (lane >> 3) + 8 * j; const LAS float* s = scr + (8 * c) * 33 + n;
        v4u o; o.x = pk2(s[0 * 33], s[1 * 33]); o.y = pk2(s[2 * 33], s[3 * 33]); o.z = pk2(s[4 * 33], s[5 * 33]); o.w = pk2(s[6 * 33], s[7 * 33]);
        { const int row_ = r0 + n, kk_ = k0 + 8 * c; *(v4u*)(WT + ((size_t)((row_ >> 4) * (K / 32) + (kk_ >> 5)) * 512 + (row_ & 15) * 32 + (kk_ & 31))) = o; } }
    LDS_WAIT(); asm volatile("" ::: "memory");
}


#define XB_TMO      128
#define XB_XCNT(j)  (256  + 64 * (j))
#define XB_XSUB(j)  (1280 + 64 * (j))
#define XB_XGEN(j)  (2304 + 64 * (j))
#define XB_TOP      3328
#define XB_TOPGEN   3392
#define XCD_BAR_WORDS 3456
#define XB_SPIN_CAP (1u << 18)

__device__ __forceinline__ unsigned xb_ld(unsigned* p)              { return __hip_atomic_load(p, __ATOMIC_RELAXED, __HIP_MEMORY_SCOPE_AGENT); }
__device__ __forceinline__ unsigned xb_add(unsigned* p, unsigned v) { return __hip_atomic_fetch_add(p, v, __ATOMIC_RELAXED, __HIP_MEMORY_SCOPE_AGENT); }
__device__ __forceinline__ unsigned xb_xcc_id() { return (unsigned)__builtin_amdgcn_s_getreg((3 << 11) | 20) & 0xFu; }
#define XB_SPIN(cond, bar) do { unsigned _sp = 0; while (cond) { __builtin_amdgcn_s_sleep(1); \
    if ((++_sp & 255u) == 0u) { if (xb_ld(&(bar)[XB_TMO])) break; if (_sp > XB_SPIN_CAP) { atomicAdd(&(bar)[XB_TMO], 1u); break; } } } } while (0)

struct XcdBarrier {
    unsigned* bar; unsigned x;
    volatile LAS unsigned* st;
};

__device__ __forceinline__ XcdBarrier xcd_barrier_post(unsigned* bar, volatile LAS unsigned* st, bool leader) {
    XcdBarrier b; b.bar = bar; b.x = xb_xcc_id(); b.st = st;
    if (leader) (void)xb_add(&bar[XB_XCNT(b.x)], 1u);
    return b;
}
__device__ __forceinline__ void xcd_barrier_complete(unsigned* bar, unsigned x, unsigned& nloc, unsigned& nx) {
    const unsigned G = gridDim.x * gridDim.y * gridDim.z;
    unsigned sum, cnt, mine, sp = 0u;
    for (;;) {
        sum = 0u; cnt = 0u; mine = 0u;
#pragma unroll
        for (unsigned j = 0; j < 16; ++j) { const unsigned c = xb_ld(&bar[XB_XCNT(j)]); sum += c; cnt += (c > 0u) ? 1u : 0u; mine = (j == x) ? c : mine; }
        if (sum == G) break;
        __builtin_amdgcn_s_sleep(1);
        if ((++sp & 255u) == 0u) { if (xb_ld(&bar[XB_TMO])) break; if (sp > XB_SPIN_CAP) { atomicAdd(&bar[XB_TMO], 1u); break; } }
    }
    nloc = mine > 0u ? mine : 1u; nx = cnt > 0u ? cnt : 1u;
}

__device__ __forceinline__ void xcd_barrier(const XcdBarrier& b, bool leader) {
    asm volatile("s_waitcnt vmcnt(0)" ::: "memory");
    __syncthreads();
    if (leader) {
        unsigned* bar = b.bar;
        __builtin_amdgcn_s_waitcnt(0);
        unsigned nloc = b.st[0], nx = b.st[1];
        if (nloc == 0u) { xcd_barrier_complete(bar, b.x, nloc, nx); b.st[0] = nloc; b.st[1] = nx; }
        const unsigned old = xb_add(&bar[XB_XSUB(b.x)], 1u);
        const unsigned gen = old / nloc;
        if (old + 1u == (gen + 1u) * nloc) {
            __builtin_amdgcn_fence(__ATOMIC_RELEASE, "agent");
            asm volatile("s_waitcnt vmcnt(0)" ::: "memory");
            const unsigned og = xb_add(&bar[XB_TOP], 1u);
            const unsigned tg = og / nx;
            if (og + 1u == (tg + 1u) * nx) xb_add(&bar[XB_TOPGEN], 1u);
            else XB_SPIN(xb_ld(&bar[XB_TOPGEN]) == tg, bar);
            __builtin_amdgcn_fence(__ATOMIC_ACQUIRE, "agent");
            xb_add(&bar[XB_XGEN(b.x)], 1u);
            asm volatile("s_waitcnt vmcnt(0)" ::: "memory");
        } else {
            XB_SPIN(xb_ld(&bar[XB_XGEN(b.x)]) == gen, bar);
            __builtin_amdgcn_fence(__ATOMIC_ACQUIRE, "agent");
            asm volatile("s_waitcnt vmcnt(0)" ::: "memory");
        }
    }
    __syncthreads();
}

namespace cmp {
using namespace att;
constexpr int L_K = 0, L_V = 32768, L_W = 65536, L_WSTRIDE = 32 * 65 * 4  , L_REL = L_W + 8 * L_WSTRIDE, L_SC = L_REL + 512, L_BT = L_SC + 8 * 128  , L_END = L_BT + 4096;
static_assert(L_END <= 140000, "cmp LDS map");
struct CmpP { const bf16* qkv; int pitch; const bf16* Kc; const bf16* Vc; const float* rel; bf16* O1; unsigned long long* sel; const bf16* gates; };
__device__ __forceinline__ void cmp_unit(const CmpP& P, int slab, int tb, char* shm, const int wave_s, const bool first) {
    int wid_l = wave_s; asm volatile("" : "+s"(wid_l));
    const int lane = lane_id_v(), wid = wid_l, tid = wid * 64 + lane, r32 = lane & 31, hi = lane >> 5;
    const int b = slab >> 2, kh = slab & 3, t0 = tb * 64;
    const int ntile = (4 * tb + 2) / 64 + 1;
    const unsigned lds0 = (unsigned)(uintptr_t)shm;
    LAS char* L = (LAS char*)(uintptr_t)lds0;
    const int tokl = r32 & 7, g = r32 >> 3, tok = t0 + 8 * wid + tokl, h = kh * 4 + g;
    const bf16* Qrow = P.qkv + (size_t)(b * SEQ + tok) * P.pitch + h * 64;
    bf16x8 qr[4];
#pragma unroll
    for (int d0 = 0; d0 < 4; ++d0) qr[d0] = *reinterpret_cast<const bf16x8*>(Qrow + d0 * 16 + hi * 8);
    const unsigned short gate_raw = P.gates[(size_t)(b * SEQ + tok) * 64 + h * 3 + 0];
    u32x4 sold[4];
#pragma unroll
    for (int i = 0; i < 4; ++i) { const int row = i * 8 + (lane >> 3), ch = lane & 7; sold[i] = *(const u32x4*)(P.O1 + (size_t)(b * SEQ + t0 + 8 * wid + (row & 7)) * DM + (kh * 4 + (row >> 3)) * 64 + ch * 8); }
    { const bf16* Kg = P.Kc + (size_t)slab * 256 * 64; const bf16* Vg = P.Vc + (size_t)slab * 256 * 64;
      u32x4 kst[4], vst[4];
      const int kc_ = tid >> 6, krow_ = tid & 63, vrow_ = 16 * ((tid >> 6) & 3) + ((tid & 63) >> 2), vcol_ = (tid >> 8) * 32 + (tid & 3) * 8;
#pragma unroll
      for (int tt = 0; tt < 4; ++tt) if (tt < ntile) { kst[tt] = *(const u32x4*)(Kg + (size_t)(tt * 64 + krow_) * 64 + kc_ * 8); vst[tt] = *(const u32x4*)(Vg + (size_t)(tt * 64 + vrow_) * 64 + vcol_); }
#pragma unroll
      for (int tt = 0; tt < 4; ++tt) if (tt < ntile) { *(LAS u32x4*)(L + L_K + tt * 8192 + kc_ * 1024 + krow_ * 16) = kst[tt]; *(LAS u32x4*)(L + L_V + tt * 8192 + (tid >> 6) * 1024 + (tid & 63) * 16) = vst[tt]; }
      if (tid < 128) { const int g = tid >> 5, bk = tid & 31; ((LAS float*)(L + L_REL))[tid] = P.rel[bk * 16 + kh * 4 + g] * LOG2E - SM_REF; } }
    if (first) { for (int d = tid; d < 4096; d += NW * 64) ((LAS unsigned char*)(L + L_BT))[d] = (unsigned char)rel_bucket_fast(d); }
    const LAS unsigned char* btL = (const LAS unsigned char*)(L + L_BT);
    LAS float* Wl = (LAS float*)(L + L_W + wid * L_WSTRIDE);
    for (int j = lane; j < 32 * 65; j += 64) Wl[j] = 0.f;
    asm volatile("s_waitcnt lgkmcnt(0)\n\ts_barrier" ::: "memory");
    const LAS float* relL = (const LAS float*)(L + L_REL) + g * 32;
    const float zf_ = opaque_zero(); f32x16 zero16; _Pragma("unroll") for (int r = 0; r < 16; ++r) zero16[r] = zf_; asm volatile("" : "+v"(zero16));
#define CBIAS(P0, P1, tt) do { const int dq_ = tok - 31 - 16 * (64 * (tt) + 4 * hi); \
    _Pragma("unroll") for (int r = 0; r < 16; ++r) { const int d0_ = dq_ - 16 * ((r & 3) + 8 * (r >> 2)), d1_ = d0_ - 512; \
        P0[r] = d0_ >= 0 ? P0[r] + relL[btL[d0_ < 0 ? 0 : d0_]] : -INFINITY; P1[r] = d1_ >= 0 ? P1[r] + relL[btL[d1_ < 0 ? 0 : d1_]] : -INFINITY; } } while (0)
    float l = 0.f;
    f32x16 o[2]; o[0] = zero16; o[1] = zero16;
    const int vb0 = (int)(lds0 + L_V) + ((lane >> 4) & 1) * 32 + (lane & 3) * 8 + (4 * hi + ((lane & 15) >> 2)) * 64;
    LAS float* Wrow = Wl + r32 * 65;
    for (int tt = 0; tt < ntile; ++tt) {
        f32x16 p0, p1; qkt(p0, p1, shm + L_K + tt * 8192, qr, zero16, r32, hi); CBIAS(p0, p1, tt);
        float s = 0.f;
#pragma unroll
        for (int r = 0; r < 16; ++r) { p0[r] = __builtin_amdgcn_exp2f(p0[r]); p1[r] = __builtin_amdgcn_exp2f(p1[r]); s += p0[r] + p1[r]; }
        l += s;
#pragma unroll
        for (int a = 0; a < 4; ++a) { const int j0 = 16 * tt + 2 * a + hi, j1 = j0 + 8;
            const float G0 = (p0[4 * a] + p0[4 * a + 1]) + (p0[4 * a + 2] + p0[4 * a + 3]), G1 = (p1[4 * a] + p1[4 * a + 1]) + (p1[4 * a + 2] + p1[4 * a + 3]);
            Wrow[j0] += G0; Wrow[j1] += G1; asm volatile("" ::: "memory");
            Wrow[j0 + 1] += p0[4 * a + 3]; Wrow[j1 + 1] += p1[4 * a + 3]; asm volatile("" ::: "memory"); }
        u32x4 pw0 = (u32x4){cvtpk_s(p0[0], p0[1]), cvtpk_s(p0[2], p0[3]), cvtpk_s(p0[4], p0[5]), cvtpk_s(p0[6], p0[7])};
        u32x4 pw1 = (u32x4){cvtpk_s(p0[8], p0[9]), cvtpk_s(p0[10], p0[11]), cvtpk_s(p0[12], p0[13]), cvtpk_s(p0[14], p0[15])};
        u32x4 pw2 = (u32x4){cvtpk_s(p1[0], p1[1]), cvtpk_s(p1[2], p1[3]), cvtpk_s(p1[4], p1[5]), cvtpk_s(p1[6], p1[7])};
        u32x4 pw3 = (u32x4){cvtpk_s(p1[8], p1[9]), cvtpk_s(p1[10], p1[11]), cvtpk_s(p1[12], p1[13]), cvtpk_s(p1[14], p1[15])};
        pv(o, vb0 + tt * 8192, __builtin_bit_cast(bf16x8, pw0), __builtin_bit_cast(bf16x8, pw1), __builtin_bit_cast(bf16x8, pw2), __builtin_bit_cast(bf16x8, pw3));
    }
#undef CBIAS
    { auto rr = __builtin_amdgcn_permlane32_swap(__float_as_uint(l), __float_as_uint(l), false, false); l = __uint_as_float(rr[0]) + __uint_as_float(rr[1]); }
    const float inv = l > 0.f ? 1.0f / l : 0.f;
    LAS float* scw = (LAS float*)(L + L_SC) + wid * 32;
    if (hi == 0) scw[r32] = inv;
    asm volatile("s_waitcnt lgkmcnt(0)" ::: "memory");
    { const int own = tb, j = lane;
      for (int tk = 0; tk < 8; ++tk) {
          float v = (Wl[(0 * 8 + tk) * 65 + j] * scw[0 * 8 + tk] + Wl[(1 * 8 + tk) * 65 + j] * scw[1 * 8 + tk]) + (Wl[(2 * 8 + tk) * 65 + j] * scw[2 * 8 + tk] + Wl[(3 * 8 + tk) * 65 + j] * scw[3 * 8 + tk]);
          const bool past = j < own; const float val = past ? v : -INFINITY;
          bool selb = (j <= own);
          if (own >= 16) {
              const unsigned bits = __float_as_uint(val); unsigned pre = 0u;
              for (int b = 30; b >= 0; --b) { const unsigned cand = pre | (1u << b); if (__popcll(__ballot(past && bits >= cand)) >= 15) pre = cand; }
              const int ngt = __popcll(__ballot(past && bits > pre));
              const unsigned long long tie = __ballot(past && bits == pre);
              const int rk = (int)__builtin_amdgcn_mbcnt_hi((unsigned)(tie >> 32), __builtin_amdgcn_mbcnt_lo((unsigned)tie, 0u));
              selb = (j == own) || (past && (bits > pre || (bits == pre && rk < 15 - ngt))); }
          const unsigned long long mk = __ballot(selb);
          if (lane == 0) P.sel[(size_t)slab * SEQ + t0 + 8 * wid + tk] = mk; } }
    asm volatile("s_waitcnt lgkmcnt(0)" ::: "memory");
    if (hi == 0) { const float gl = bflo((unsigned)gate_raw); scw[r32] = inv / (1.0f + __expf(-gl)); }
    asm volatile("s_waitcnt lgkmcnt(0)" ::: "memory");
    LAS bf16* stg = (LAS bf16*)Wl;
#pragma unroll
    for (int r = 0; r < 16; ++r) { const int orow = crow(r, hi); const float sc = scw[orow];
#pragma unroll
        for (int d0 = 0; d0 < 2; ++d0) { const unsigned pk = cvtpk_s(o[d0][r] * sc, 0.f); stg[orow * 64 + d0 * 32 + r32] = (bf16)(pk & 0xffffu); } }
    asm volatile("s_waitcnt lgkmcnt(0)" ::: "memory");
#pragma unroll
    for (int i = 0; i < 4; ++i) { const int row = i * 8 + (lane >> 3), ch = lane & 7; const u32x4 v = *(const LAS u32x4*)(stg + row * 64 + ch * 8);
        bf16* gp = P.O1 + (size_t)(b * SEQ + t0 + 8 * wid + (row & 7)) * DM + (kh * 4 + (row >> 3)) * 64 + ch * 8;
        const u32x4 s = sold[i]; u32x4 w;
#pragma unroll
        for (int k = 0; k < 4; ++k) w[k] = cvtpk_s(bflo(v[k]) + bflo(s[k]), bfhi(v[k]) + bfhi(s[k]));
        *(u32x4*)gp = w; }
    asm volatile("s_waitcnt lgkmcnt(0)\n\ts_barrier" ::: "memory");
}
}

constexpr size_t MiB = 1u << 20;
constexpr size_t WS_WIN = 0;
constexpr size_t WS_WOUT = 6 * MiB;
constexpr size_t WS_WUP = 8 * MiB;
constexpr size_t WS_WDN = 16 * MiB;
constexpr size_t WS_WC1 = 24 * MiB;
constexpr size_t WS_XB = 26 * MiB;
constexpr size_t WS_R = 58 * MiB;
constexpr size_t WS_O1 = WS_R + 96 * MiB;
constexpr size_t WS_RSSA = 186 * MiB;
constexpr size_t WS_RSSB = 187 * MiB;
constexpr size_t WS_TAB = 188 * MiB;
constexpr size_t WS_ML = 189 * MiB;
constexpr size_t WS_KC = 193 * MiB;
constexpr size_t WS_VC = 201 * MiB;
constexpr size_t WS_HID = 210 * MiB;
constexpr size_t WS_KCMP = 214 * MiB;
constexpr size_t WS_VCMP = 215 * MiB;
constexpr size_t WS_SEL = 216 * MiB;
constexpr size_t WS_FLOG = 217 * MiB;
constexpr size_t WS_KMEAN = 218 * MiB;
constexpr size_t WS_POSB = 219 * MiB;
constexpr size_t WS_BAR = 219 * MiB + 524288;
constexpr size_t WS_END = 220 * MiB;
constexpr int LDS_BYTES = 147456;
constexpr int LDS_RSTD = 131072;
constexpr int LDS_MISC = LDS_BYTES - 64;

struct Args { const float* in[17]; float* out; unsigned char* ws; };

__device__ __forceinline__ void x_to_bf16_rss(const float* x, bf16* xb, float* rss, int gw, int NGW, int lane) {
    for (int m = gw; m < MTOK; m += NGW) {
        const f32x4* xr = (const f32x4*)(x + (size_t)m * DM) + lane; f32x4 v[4]; float s = 0.f;
#pragma unroll
        for (int j = 0; j < 4; ++j) { v[j] = xr[64 * j]; s += (v[j][0] * v[j][0] + v[j][1] * v[j][1]) + (v[j][2] * v[j][2] + v[j][3] * v[j][3]); }
        s = wave_sum(s, lane);
        unsigned long long* o8 = (unsigned long long*)(xb + (size_t)(m >> 4) * (DM / 32) * 512 + (lane >> 3) * 512 + (m & 15) * 32 + 4 * (lane & 7));
#pragma unroll
        for (int j = 0; j < 4; ++j) o8[(8 * j) * 128] = (unsigned long long)pk2(v[j][0], v[j][1]) | ((unsigned long long)pk2(v[j][2], v[j][3]) << 32);
        if (lane < 16) rss[(size_t)m * 16 + lane] = (lane == 0) ? s : 0.f;
    }
}
__device__ __forceinline__ void fox_logf(const bf16* x, const float* rss, const float* g, const float* wfox, const float* bf, float* flog, LAS float* wg, int tid, int gw, int NGW, int lane) {
    for (int i = tid; i < 1024 * 16; i += 512) { const int k = i >> 4, h = i & 15; wg[h * 1024 + k] = g[k] * wfox[(size_t)k * FOX_LDW + 3072 + h]; }
    __syncthreads();
    for (int m = gw; m < MTOK; m += NGW) {
        const unsigned long long* xr = (const unsigned long long*)(x + (size_t)(m >> 4) * (DM / 32) * 512 + (lane >> 3) * 512 + (m & 15) * 32 + 4 * (lane & 7)); float acc[16];
#pragma unroll
        for (int h = 0; h < 16; ++h) acc[h] = 0.f;
        f32x4 xv[4];
#pragma unroll
        for (int j = 0; j < 4; ++j) { const unsigned long long w = xr[(8 * j) * 128]; const unsigned lo = (unsigned)w, hi2 = (unsigned)(w >> 32);
            xv[j] = (f32x4){__uint_as_float(lo << 16), __uint_as_float(lo & 0xffff0000u), __uint_as_float(hi2 << 16), __uint_as_float(hi2 & 0xffff0000u)}; }
#pragma unroll 1
        for (int j = 0; j < 4; ++j) { const f32x4 v = (j == 0) ? xv[0] : ((j == 1) ? xv[1] : ((j == 2) ? xv[2] : xv[3]));
#pragma unroll
            for (int h = 0; h < 16; ++h) { const f32x4 w = *(const LAS f32x4*)(wg + h * 1024 + 256 * j + 4 * lane); acc[h] += (v[0] * w[0] + v[1] * w[1]) + (v[2] * w[2] + v[3] * w[3]); } }
        float mine = 0.f;
#pragma unroll
        for (int h = 0; h < 16; ++h) { const float s = wave_sum(acc[h], lane); if (lane == h) mine = s; }
        if (lane < 16) {
            const float rstd = pg8::row_rstd(rss, m);
            const float z = mine * rstd + bf[lane];
            const float e = __expf(-fabsf(z)); const float l1p = (e < 0.03125f) ? e * (1.0f - e * (0.5f - e * (1.0f / 3.0f))) : __logf(1.0f + e);
            const float lf = fminf(z, 0.f) - l1p;
            const int b = m / SEQ, t = m % SEQ; flog[(size_t)(b * 16 + lane) * SEQ + t] = lf;
        }
    }
}
__device__ __forceinline__ void fox_logf_mfma(const bf16* x, const float* rss, const float* g, const float* wfox, const float* bf, float* flog, LAS unsigned char* L, int tid, int gw, int lane) {
    typedef __attribute__((ext_vector_type(8))) short bf16x8_t; typedef float f32x4_t __attribute__((ext_vector_type(4)));
    constexpr int WST = 1024 + 8;
    LAS bf16* whi = (LAS bf16*)L; LAS bf16* wlo = whi + 16 * WST;
    for (int i = tid; i < 1024 * 16; i += 512) { const int k = i >> 4, h = i & 15; const float v = g[k] * wfox[(size_t)k * FOX_LDW + 3072 + h];
        const unsigned hb = f2bf(v); const float vh = __uint_as_float(hb << 16); whi[h * WST + k] = (bf16)hb; wlo[h * WST + k] = (bf16)f2bf(v - vh); }
    __syncthreads();
    if ((gw & 7) < 4) {
        const int grp = (gw >> 3) * 4 + (gw & 7);
        const int r = lane & 15, kg = lane >> 4;
        const bf16* xg = x + (size_t)grp * (DM / 32) * 512 + r * 32 + kg * 8;
        f32x4_t acc = {0.f, 0.f, 0.f, 0.f};
#pragma unroll 1
        for (int half = 0; half < 2; ++half) {
            bf16x8_t xf[16];
#pragma unroll
            for (int j = 0; j < 16; ++j) xf[j] = *(const bf16x8_t*)(xg + (size_t)(half * 16 + j) * 512);
#pragma unroll
            for (int j = 0; j < 16; ++j) { const int k0 = (half * 16 + j) * 32 + kg * 8;
                const bf16x8_t a_hi = *(const LAS bf16x8_t*)(whi + r * WST + k0), a_lo = *(const LAS bf16x8_t*)(wlo + r * WST + k0);
                acc = __builtin_amdgcn_mfma_f32_16x16x32_bf16(a_hi, xf[j], acc, 0, 0, 0);
                acc = __builtin_amdgcn_mfma_f32_16x16x32_bf16(a_lo, xf[j], acc, 0, 0, 0); }
        }
        const int m = grp * 16 + r;
        const float rstd = pg8::row_rstd(rss, m);
        const int b = m / SEQ, t = m % SEQ;
#pragma unroll
        for (int i = 0; i < 4; ++i) { const int h = 4 * kg + i;
            const float z = acc[i] * rstd + bf[h];
            const float e = __expf(-fabsf(z)); const float l1p = (e < 0.03125f) ? e * (1.0f - e * (0.5f - e * (1.0f / 3.0f))) : __logf(1.0f + e);
            flog[(size_t)(b * 16 + h) * SEQ + t] = fminf(z, 0.f) - l1p; }
    }
}
__device__ __forceinline__ void scan4096(float* p, int lane) {
    f32x4* q = (f32x4*)(p + lane * 64); float tot = 0.f;
    for (int i = 0; i < 16; ++i) { const f32x4 v = q[i]; tot += (v[0] + v[1]) + (v[2] + v[3]); }
    float incl = tot;
#pragma unroll
    for (int o = 1; o < 64; o <<= 1) { const float up = __int_as_float(__builtin_amdgcn_ds_bpermute((lane - o) << 2, __float_as_int(incl))); if (lane >= o) incl += up; }
    float run = incl - tot;
    for (int i = 0; i < 16; ++i) { f32x4 v = q[i]; v[0] += run; v[1] += v[0]; v[2] += v[1]; v[3] += v[2]; run = v[3]; q[i] = v; }
}
__device__ __forceinline__ void cmp2_rows(const bf16* hid, const float* w2  , const float* kg, bf16* Kcmp, bf16* Vcmp, LAS float* w2L, int tid, int gw, int NGW, int lane) {
    const int br = (gw * 2 >= NGW) ? 1 : 0, gwb = gw - br * (NGW / 2);
    { float t_[32];
#pragma unroll
      for (int i = 0; i < 32; ++i) t_[i] = w2[br * 256 * 64 + tid + 512 * i];
#pragma unroll
      for (int i = 0; i < 32; ++i) w2L[br * 256 * 64 + tid + 512 * i] = t_[i]; }
    __syncthreads();
    for (int row = gwb; row < 4096; row += NGW / 2) {
        const int r = br * 4096 + row;
        const unsigned long long hv = *((const unsigned long long*)(hid + (size_t)r * 256) + lane);
        const unsigned lo = (unsigned)hv, hi2 = (unsigned)(hv >> 32);
        const float h0 = __uint_as_float(lo << 16), h1 = __uint_as_float(lo & 0xffff0000u), h2 = __uint_as_float(hi2 << 16), h3 = __uint_as_float(hi2 & 0xffff0000u);
        const LAS float* wl = w2L + br * 256 * 64 + lane; float acc = 0.f;
        for (int jl = 0; jl < 64; ++jl) {
            const float a0 = __uint_as_float(__builtin_amdgcn_readlane(__float_as_uint(h0), jl)), a1 = __uint_as_float(__builtin_amdgcn_readlane(__float_as_uint(h1), jl));
            const float a2 = __uint_as_float(__builtin_amdgcn_readlane(__float_as_uint(h2), jl)), a3 = __uint_as_float(__builtin_amdgcn_readlane(__float_as_uint(h3), jl));
            acc += a0 * wl[(4 * jl) * 64]; acc += a1 * wl[(4 * jl + 1) * 64]; acc += a2 * wl[(4 * jl + 2) * 64]; acc += a3 * wl[(4 * jl + 3) * 64]; }
        if (br == 0) { const float ss = wave_sum(acc * acc, lane); acc = acc * rsqrtf(ss * (1.0f / 64.0f) + RMS_EPS) * kg[lane]; Kcmp[(size_t)row * 64 + lane] = (bf16)f2bf(acc); }
        else Vcmp[(size_t)row * 64 + lane] = (bf16)f2bf(acc);
    }
}

__device__ __forceinline__ void cmp2_mfma(const bf16* hid, const float* w2  , const float* kg_, bf16* Kcmp, bf16* Vcmp, LAS unsigned char* L, int tid, int wave, int lane, int br, int rowbase) {
    typedef __attribute__((ext_vector_type(8))) short bf16x8_t; typedef float f32x4_t __attribute__((ext_vector_type(4)));
    constexpr int WST = 256 + 8;
    LAS bf16* whi = (LAS bf16*)L; LAS bf16* wlo = whi + 64 * WST;
    for (int i = tid; i < 256 * 64; i += 512) { const int k = i >> 6, o = i & 63; const float v = w2[br * 256 * 64 + i];
        const unsigned hb = f2bf(v); const float vh = __uint_as_float(hb << 16); whi[o * WST + k] = (bf16)hb; wlo[o * WST + k] = (bf16)f2bf(v - vh); }
    __syncthreads();
#pragma unroll 1
    for (int gq = 0; gq < 2; ++gq) {
        const int row0 = rowbase + (wave * 2 + gq) * 16;
        const int r = lane & 15, kq = lane >> 4;
        const bf16* hp = hid + (size_t)(br * 4096 + row0 + r) * 256 + kq * 8;
        bf16x8_t xf[8];
#pragma unroll
        for (int j = 0; j < 8; ++j) xf[j] = *(const bf16x8_t*)(hp + j * 32);
        f32x4_t acc[4];
#pragma unroll
        for (int ot = 0; ot < 4; ++ot) { acc[ot] = (f32x4_t){0.f, 0.f, 0.f, 0.f};
#pragma unroll
            for (int j = 0; j < 8; ++j) { const int k0 = j * 32 + kq * 8;
                const bf16x8_t a_hi = *(const LAS bf16x8_t*)(whi + (ot * 16 + r) * WST + k0), a_lo = *(const LAS bf16x8_t*)(wlo + (ot * 16 + r) * WST + k0);
                acc[ot] = __builtin_amdgcn_mfma_f32_16x16x32_bf16(a_hi, xf[j], acc[ot], 0, 0, 0);
                acc[ot] = __builtin_amdgcn_mfma_f32_16x16x32_bf16(a_lo, xf[j], acc[ot], 0, 0, 0); } }
        float sc = 1.f;
        if (br == 0) { float ss = 0.f;
#pragma unroll
            for (int ot = 0; ot < 4; ++ot) ss += (acc[ot][0] * acc[ot][0] + acc[ot][1] * acc[ot][1]) + (acc[ot][2] * acc[ot][2] + acc[ot][3] * acc[ot][3]);
            ss += shx(ss, 16, lane); ss += shx(ss, 32, lane);
            sc = rsqrtf(ss * (1.0f / 64.0f) + RMS_EPS); }
        bf16* op = (br == 0 ? Kcmp : Vcmp) + (size_t)(row0 + r) * 64 + 4 * kq;
#pragma unroll
        for (int ot = 0; ot < 4; ++ot) { float v[4];
#pragma unroll
            for (int i = 0; i < 4; ++i) v[i] = (br == 0) ? acc[ot][i] * sc * kg_[ot * 16 + 4 * kq + i] : acc[ot][i];
            *(unsigned long long*)(op + ot * 16) = (unsigned long long)pk2(v[0], v[1]) | ((unsigned long long)pk2(v[2], v[3]) << 32); }
    }
}

#define WJ_DECL(id, PE, PW, PL, PN, PK, PNP, PWT, PG, PH) const float* wjW_##id = (PW); const int wjl_##id = (PL), wjn_##id = (PN), wjk_##id = (PK), wjb_##id = (PNP) / 32, wjc_##id = (PE) ? ((PK) / 64) * wjb_##id : 0; \
    bf16* wjT_##id = (PWT); const float* wjg_##id = (PG); const bool wjh_##id = (PH); const int wjr_##id = (gw - jbase % NGW + NGW) % NGW; const bool wjx_##id = wjr_##id < wjc_##id; const int wji_##id = wjx_##id ? wjr_##id : 0; jbase += wjc_##id; float wjv_##id[32]
#define WJ_LOAD(id) wt_load(wjW_##id, wjl_##id, wjn_##id, wjb_##id, wji_##id, lane, wjv_##id)
#define WJ_STORE(id) do { if (wjx_##id) wt_store(wjk_##id, wjb_##id, wjT_##id, wjg_##id, wjh_##id, scrw, wji_##id, lane, wjv_##id); } while (0)

__device__ __forceinline__ void wjob(const float* W, int ldw, int N, int K, int Npad, bf16* WT, const float* gs, bool headperm, int& base, LAS float* scr, int gw, int NGW, int lane) {
    const int nblk = Npad / 32, nit = (K / 64) * nblk;
    const int first = (gw - base % NGW + NGW) % NGW;
    for (int it = first; it < nit; it += NGW) wt_item(W, ldw, N, K, nblk, WT, gs, headperm, scr, it, lane);
    base += nit;
}
__global__ void __launch_bounds__(512, 2) fwd_mega(Args args) {
    extern __shared__ __attribute__((aligned(16))) unsigned char lds[];
    cg::grid_group grid = cg::this_grid();
    constexpr int G = 256; const int bx = blockIdx.x;
    const int wave_s = __builtin_amdgcn_readfirstlane((int)threadIdx.x >> 6);
    const int vcu_top = (G % 8 == 0) ? (bx % 8) * (G / 8) + bx / 8 : bx; const int vcu = vcu_top;
    const int NGW = G * 8;
    LAS unsigned char* ldsL = (LAS unsigned char*)lds;
    unsigned char* const ws_top = args.ws; unsigned char* const ws = ws_top;
    float* const xres = args.out;
#define x_in args.in[0]
#define rel args.in[1]
#define attn_norm args.in[2]
#define mlp_norm args.in[3]
#define q_gain args.in[4]
#define k_gain args.in[5]
#define w_out args.in[6]
#define w_up args.in[7]
#define w_dn args.in[8]
#define cmp_pos args.in[11]
#define cmp_w1 args.in[12]
#define cmp_w2 args.in[13]
#define fox_bf args.in[15]
#define Win ((bf16*)(ws + WS_WIN))
#define Wout ((bf16*)(ws + WS_WOUT))
#define Wup ((bf16*)(ws + WS_WUP))
#define Wdn ((bf16*)(ws + WS_WDN))
#define Wc1 ((bf16*)(ws + WS_WC1))
#define XB ((bf16*)(ws + WS_XB))
#define QKV ((bf16*)(ws + WS_R))
#define QB QKV
#define KI ((bf16*)(ws + WS_R + 32 * MiB))
#define VI ((bf16*)(ws + WS_R + 64 * MiB))
#define KSI ((bf16*)(ws + WS_R + 32 * MiB))
#define VSI ((bf16*)(ws + WS_R + 40 * MiB))
#define KWI ((bf16*)(ws + WS_R + 48 * MiB))
#define VWI ((bf16*)(ws + WS_R + 56 * MiB))
#define GATES ((bf16*)(ws + WS_R + 64 * MiB))
#define O1 ((bf16*)(ws + WS_O1))
#define O2 XB
#define HB ((bf16*)(ws + WS_R))
#define rssA ((float*)(ws + WS_RSSA))
#define rssB ((float*)(ws + WS_RSSB))
#define TAB ((float*)(ws + WS_TAB))
#define ML ((float*)(ws + WS_ML))
#define KC ((bf16*)(ws + WS_KC))
#define VC ((bf16*)(ws + WS_VC))
#define HID ((bf16*)(ws + WS_HID))
#define KCMP ((bf16*)(ws + WS_KCMP))
#define VCMP ((bf16*)(ws + WS_VCMP))
#define SEL ((unsigned long long*)(ws + WS_SEL))
#define FLOG ((float*)(ws + WS_FLOG))
#define KMEAN ((float*)(ws + WS_KMEAN))
#define POSB ((float*)(ws + WS_POSB))
#define POSBP ((float*)(ws + WS_POSB + 4096))
#define PHASE_TID int wave_l_ = wave_s; asm volatile("" : "+s"(wave_l_)); const int lane = lane_id_v(), wave = wave_l_, tid = wave * 64 + lane, gw = vcu * 8 + wave; LAS float* scrw = (LAS float*)(ldsL + wave * 16384); (void)tid; (void)lane; (void)gw; (void)scrw
#define W_IN_PTR(L) ((L) == 0 ? args.in[9] : ((L) == 1 ? args.in[10] : ((L) == 2 ? args.in[14] : args.in[16])))
#define JOB_IN(L) wjob(W_IN_PTR(L), (L) == 1 ? NSA_N : ((L) == 2 ? FOX_LDW : 3072), (L) == 1 ? NSA_N : 3072, 1024, (L) == 1 ? NSA_NP : 3072, Win, attn_norm + (L) * DM, true, jbase, scrw, gw, NGW, lane)
#define JOB_OUT(L) wjob(w_out + (size_t)(L) * DM * DM, DM, DM, DM, DM, Wout, nullptr, false, jbase, scrw, gw, NGW, lane)
#define JOB_UP(L) wjob(w_up + (size_t)(L) * DM * FF, FF, FF, DM, FF, Wup, mlp_norm + (L) * DM, false, jbase, scrw, gw, NGW, lane)
#define JOB_DN(L) wjob(w_dn + (size_t)(L) * FF * DM, DM, DM, FF, DM, Wdn, nullptr, false, jbase, scrw, gw, NGW, lane)

    volatile LAS unsigned* misc = (volatile LAS unsigned*)(ldsL + LDS_MISC);
    { const int l0 = lane_id_v(); if (wave_s == 0 && l0 < 16) misc[l0] = 0u; }
    __syncthreads();
    XcdBarrier xbar = xcd_barrier_post((unsigned*)(ws + WS_BAR), misc, (wave_s == 0 && lane_id_v() == 0));
#define XBAR() xcd_barrier(xbar, (wave_s == 0 && lane_id_v() == 0))
    grid.sync();

    for (int ph = -1; ph < 32; ++ph) {
      { const int L = ph >> 3, st = ph < 0 ? 99 : (ph & 7);
        int vcu = vcu_top; asm volatile("" : "+s"(vcu));
        unsigned char* ws = ws_top; asm volatile("" : "+s"(ws));
        bool did = false;
        if (ph < 0) {
        PHASE_TID;
        int jbase = 0;
        WJ_DECL(pi, true, W_IN_PTR(0), 3072, 3072, 1024, 3072, Win, attn_norm, true);
        WJ_DECL(pa, true, cmp_w1, 256, 256, 2048, 256, Wc1, (const float*)nullptr, false);
        WJ_DECL(pb, true, cmp_w1 + 2048 * 256, 256, 256, 2048, 256, Wc1 + 256 * 2048, (const float*)nullptr, false);
        WJ_LOAD(pi); WJ_LOAD(pa); WJ_STORE(pi); WJ_LOAD(pb); WJ_STORE(pa); WJ_STORE(pb);
        x_to_bf16_rss(x_in, XB, rssA, gw, NGW, lane);
        const int gt = vcu * 512 + tid, NGT = G * 512;
        for (int i = gt; i < 3 * 16 * 4096; i += NGT) { const int p = i / 65536, h = (i >> 12) & 15, d = i & 4095; const int dil = (p == 0) ? 1 : (p == 1 ? 4 : 16);
            TAB[i] = rel[rel_bucket(d * dil) * 16 + h] * LOG2E; }
        for (int i = gt; i < 64 * 16 * 64; i += NGT) KMEAN[i] = 0.f;
        if ((gw & 7) == 7) { const int id_ = gw >> 3; const int br = id_ >> 7, cg = (id_ >> 5) & 3, kr = id_ & 31, c = cg * 64 + lane; const float* pp = cmp_pos + br * 2048 + kr * 64; const float* ww = cmp_w1 + ((size_t)br * 2048 + kr * 64) * 256 + c; float s = 0.f;
#pragma unroll
            for (int k = 0; k < 64; ++k) s += pp[k] * ww[(size_t)k * 256];
            POSBP[(br * 32 + kr) * 256 + c] = s; }
        did = true; }

        if (st == 0) {
            const int Np = (L == 1) ? NSA_NP : 3072;
            pg8::Gemm g{XB, Win, MTOK, Np, DM, DM, 1}; pg8::StaticOrder S; S.init(MTOK, Np, G, bx);
            unsigned long long modes;
            if (L == 1) modes = 0x55ull | (3ull << 8) | (3ull << 10) | (2ull << 12) | (0ull << 14) | (2ull << 16) | (0ull << 18) | (0ull << 20);
            else modes = 0x55ull | (0xAAull << 8);
            auto pre = [&](int tid) __attribute__((always_inline)) { if (tid < 128) ((LAS float*)(ldsL + LDS_RSTD + 4096))[tid] = (tid < 64) ? q_gain[L * HD + tid] : k_gain[L * HD + tid - 64]; pg8::rstd_prepass(S, rssA, (LAS float*)(ldsL + LDS_RSTD), tid); };
            unsigned long long dk = 0ull, isel = 0ull, ih0 = 0ull;
            if (L == 1) { dk = (1ull << 18) | (2ull << 21) | (1ull << 24) | (2ull << 27) | (4ull << 30); isel = (1ull << 21) | (2ull << 24) | (3ull << 27); ih0 = (6ull << 24) | (7ull << 28) | (8ull << 32) | (9ull << 36); }
            else if (L >= 2) { dk = (1ull << 12) | (1ull << 15) | (1ull << 18) | (1ull << 21) | (2ull << 24) | (2ull << 27) | (2ull << 30) | (2ull << 33); isel = (1ull << 24) | (1ull << 27) | (1ull << 30) | (1ull << 33);
                ih0 = (4ull << 16) | (4ull << 20) | (4ull << 24) | (4ull << 28) | (8ull << 32) | (8ull << 36) | (8ull << 40) | (8ull << 44); }
            pg8::EpiIn E{QKV, L == 0 ? 3072 : 1024, (const LAS float*)(ldsL + LDS_RSTD), (const LAS float*)(ldsL + LDS_RSTD + 4096), (const LAS float*)(ldsL + LDS_RSTD + 4096 + 256), modes, KC, VC, 4, (L == 3) ? KMEAN : nullptr,
                         dk, isel, ih0, L == 1 ? 4 : 16, L == 1 ? KSI : KI, L == 1 ? VSI : VI, KWI, VWI, GATES};
            pg8::gemm_phase<pg8::EpiIn, pg8::StaticOrder, true, true>(ldsL, g, S, E, wave_s, pre);
            if (L == 2) { PHASE_TID; __syncthreads(); fox_logf_mfma(XB, rssA, attn_norm + 2 * DM, args.in[14], fox_bf, FLOG, ldsL, tid, gw, lane); }
            did = true;
        }
        if (st == 1) {
            PHASE_TID; int jbase = 0;
            WJ_DECL(o, true, w_out + (size_t)L * DM * DM, DM, DM, DM, DM, Wout, (const float*)nullptr, false);
            WJ_DECL(u, true, w_up + (size_t)L * DM * FF, FF, FF, DM, FF, Wup, mlp_norm + L * DM, false);
            WJ_DECL(d, true, w_dn + (size_t)L * FF * DM, DM, DM, FF, DM, Wdn, (const float*)nullptr, false);
            const int Ln = L <= 2 ? L + 1 : 3;
            WJ_DECL(i, L <= 2, W_IN_PTR(Ln), Ln == 1 ? NSA_N : (Ln == 2 ? FOX_LDW : 3072), Ln == 1 ? NSA_N : 3072, 1024, Ln == 1 ? NSA_NP : 3072, Win, attn_norm + Ln * DM, true);
            WJ_LOAD(o); WJ_LOAD(u); WJ_STORE(o); WJ_LOAD(d); WJ_STORE(u); WJ_LOAD(i); WJ_STORE(d); WJ_STORE(i);
            if (L == 0 && vcu == 0) { const int br = tid >> 8, c = tid & 255; float s = 0.f; for (int kr = 0; kr < 32; ++kr) s += POSBP[(br * 32 + kr) * 256 + c]; POSB[tid] = s; }
            __syncthreads();
            did = true;
        }
        if (L == 1 && st == 1) {
            {
                const int br = (bx >> 4) & 1;
                pg8::Gemm g{br == 0 ? KC : VC, Wc1 + (size_t)br * 256 * 2048, 4096, 256, 2048, 1024}; pg8::StaticOrder S; S.init(4096, 256, G, bx < 32 ? (bx & 15) : 100000);
                pg8::EpiCmp E{HID + (size_t)br * 4096 * 256, POSB + br * 256};
                pg8::gemm_phase<pg8::EpiCmp, pg8::StaticOrder, true, true>(ldsL, g, S, E, wave_s);
                __syncthreads();
                if (bx < 32) {
                    PHASE_TID; pg8::Unit u0; S.next(0, u0);
                    cmp2_mfma(HID, cmp_w2, k_gain + 1 * HD, KCMP, VCMP, ldsL, tid, wave, lane, br, u0.pm * 256);
                    __syncthreads(); }
            }
        }
        {
            const int relv = (L == 0 && st == 1) ? 0 : ((L == 0 && st == 2) ? 1 : ((L == 1 && st == 1) ? 2 : -1));
            if (relv >= 0) {
                const int vq = vcu & 31;
                const int ni = relv == 0 ? 8 : (relv == 2 ? (vq < 4 ? 0 : (vq < 20 ? 5 : 4)) : 4);
                auto mk = [&](int i) __attribute__((always_inline)) -> att::UnitP {
                    const bool xtra = (relv == 2 && i == 4);
                    const int bh = relv == 0 ? ((vcu >> 1) & 63) : (xtra ? 8 * (vcu >> 5) : (vcu >> 2)), sub = relv == 0 ? ((vcu & 1) * 8 + i) : (xtra ? (vq - 4) : ((vcu & 3) * 4 + i)), b = bh >> 4, h = bh & 15;
                    att::UnitP P{}; P.tfill = (i == 0) || xtra;
                    if (relv == 0) {
                        const int part = vcu >> 7, dil = part == 0 ? 1 : 4, nqb = (SEQ / dil) / 256, res = sub / nqb, qb = sub % nqb;
                        const size_t row0 = (size_t)b * SEQ + res;
                        P.Qp = QKV + row0 * 3072 + h * 64; P.Kp = P.Qp + 1024; P.Vp = P.Qp + 2048; P.qrs = P.krs = (long)dil * 3072;
                        P.q0 = qb * 256; const int tl = qb * 4 - 2; P.t_lo = tl & ~(tl >> 31); P.NT = qb * 4 + 4 - P.t_lo;
                        P.tg = TAB + ((size_t)part * 16 + h) * 4096; P.W = 128; P.tCmax = 128; P.tlen = 640; P.tsh = 128 - (P.q0 - 64 * P.t_lo);
                        P.Op = (part == 0 ? O1 : O2) + row0 * DM + h * 64; P.ors = (long)dil * DM;
                        P.ml_out = ML + (size_t)part * MTOK * 32 + (row0 * 16 + h) * 2; P.mls = (long)dil * 32;
                    } else if (relv == 1) {
                        const int res = sub; const size_t row0 = (size_t)b * SEQ + res;
                        P.Qp = QKV + row0 * 3072 + h * 64; P.Kp = P.Qp + 1024; P.Vp = P.Qp + 2048; P.qrs = P.krs = 16L * 3072;
                        P.q0 = 0; P.t_lo = 0; P.NT = 4;
                        P.tg = TAB + ((size_t)2 * 16 + h) * 4096; P.W = 128; P.tCmax = 128; P.tlen = 640; P.tsh = 128;
                        P.Op = O1 + row0 * DM + h * 64; P.ors = 16L * DM; P.mls = 16L * 32;
                        P.S1 = O1 + row0 * DM + h * 64; P.S2 = O2 + row0 * DM + h * 64;
                        P.ml1 = ML + (row0 * 16 + h) * 2; P.ml2 = ML + (size_t)MTOK * 32 + (row0 * 16 + h) * 2;
                    } else {
                        const int qb = sub, kh = h >> 2; const size_t row0 = (size_t)b * SEQ;
                        P.Qp = QB + row0 * DM + h * 64; P.qrs = DM; P.img = 1; P.Kp = KWI + (size_t)((b * 4 + kh) * 64) * 4096; P.Vp = VWI + (size_t)((b * 4 + kh) * 64) * 4096;
                        P.q0 = qb * 256; const int tl = qb * 4 - 8; P.t_lo = tl & ~(tl >> 31); P.NT = qb * 4 + 4 - P.t_lo;
                        P.tg = TAB + (size_t)h * 4096; P.W = 511; P.tCmax = 512; P.tlen = 1024; P.tsh = 512 - (P.q0 - 64 * P.t_lo);
                        P.Op = O1 + row0 * DM + h * 64; P.ors = DM;
                        P.gate = GATES + row0 * 64 + h * 3 + 2; P.grs = 64;
                    }
                    return P; };
                att::bf16x8 qrc[4]; { const int z_ = __float_as_int(opaque_zero()); const att::u32x4 z4_ = {(unsigned)z_, (unsigned)z_, (unsigned)z_, (unsigned)z_}; qrc[0] = qrc[1] = qrc[2] = qrc[3] = __builtin_bit_cast(att::bf16x8, z4_); } unsigned long long mkc = ~0ull;
#pragma unroll 1
                for (int i = 0; i < ni; ++i) {
                    const bool seam = (i + 1 < ni) && !(relv == 2 && i == 3);
                    att::UnitP P = mk(i); P.pre = (i > 0) && !(relv == 2 && i == 4);
                    if (seam) { const att::UnitP N = mk(i + 1); P.nQp = N.Qp; P.nKp = N.Kp; P.nVp = N.Vp; P.nq0 = N.q0; P.ntlo = N.t_lo; P.nNT = N.NT; }
                    if (relv == 2) att::attn_unit<att::HK_REL, 8, false>(P, (char*)lds, wave_s, qrc, mkc);
                    else att::attn_unit<att::HK_REL, 8, true>(P, (char*)lds, wave_s, qrc, mkc);
                }
                did = true;
            }
        }
        if (L == 1 && st == 3) {
            cmp::CmpP CP{QB, DM, KCMP, VCMP, rel, O1, SEL, GATES};
            for (int k = 0; k < 4; ++k) { const int tb0 = vcu & 63; cmp::cmp_unit(CP, 4 * k + (vcu >> 6), (k & 1) ? 63 - tb0 : tb0, (char*)lds, wave_s, k == 0); }
            did = true;
        }
        {
            const int mv = (L == 1 && st == 4) ? 0 : ((L == 3 && st == 1) ? 1 : -1);
            if (mv >= 0) {
                auto mk = [&](int i) __attribute__((always_inline)) -> att::UnitP {
                    const int bh = vcu >> 2, s = 2 * (vcu & 3) + (i >> 1), b = bh >> 4, h = bh & 15, kh = h >> 2;
                    {
                        const int k = i & 1; const int qb = k == 0 ? s : 15 - s;
                        att::UnitP P{}; P.tfill = (i == 0); P.tCmax = 3840; P.toff = 2496; P.tlen = 4352 - 2496;
                        const size_t row0 = (size_t)b * SEQ;
                        P.q0 = qb * 256; P.t_lo = 0; P.NT = 4 * (qb + 1); P.tg = TAB + (size_t)h * 4096; P.W = 1 << 20; P.tsh = 3840 - P.q0;
                        P.Op = O1 + row0 * DM + h * 64; P.ors = DM;
                        if (mv == 0) {
                            P.Qp = QB + row0 * DM + h * 64; P.qrs = DM; P.img = 1; P.Kp = KSI + (size_t)((b * 4 + kh) * 64) * 4096; P.Vp = VSI + (size_t)((b * 4 + kh) * 64) * 4096;
                            P.mshift = 0; P.mask64 = SEL + (size_t)(b * 4 + kh) * SEQ;
                            P.S1 = P.Op; P.accum = 1; P.gate = GATES + row0 * 64 + h * 3 + 1; P.grs = 64;
                        } else {
                            P.Qp = QB + row0 * DM + h * 64; P.qrs = DM; P.img = 1; P.Kp = KI + (size_t)(bh * 64) * 4096; P.Vp = VI + (size_t)(bh * 64) * 4096;
                            P.mshift = 2; P.kmean = KMEAN + (size_t)bh * 1024; P.qb = qb;
                        }
                        return P;
                    } };
                att::bf16x8 qrc[4]; { const int z_ = __float_as_int(opaque_zero()); const att::u32x4 z4_ = {(unsigned)z_, (unsigned)z_, (unsigned)z_, (unsigned)z_}; qrc[0] = qrc[1] = qrc[2] = qrc[3] = __builtin_bit_cast(att::bf16x8, z4_); } unsigned long long mkc = ~0ull;
#pragma unroll 1
                for (int i = 0; i < 4; ++i) {
                    att::UnitP P = mk(i); P.pre = (i > 0);
                    if (i + 1 < 4) { const att::UnitP N = mk(i + 1); P.nQp = N.Qp; P.nKp = N.Kp; P.nVp = N.Vp; P.nq0 = N.q0; P.ntlo = N.t_lo; P.nNT = N.NT; }
                    att::attn_unit<att::HK_RELMASK, 8>(P, (char*)lds, wave_s, qrc, mkc);
                }
                did = true;
            }
        }
        if (L == 2 && st == 1) {
            auto mk = [&](int i) __attribute__((always_inline)) -> att::UnitP {
                const int bh = vcu >> 2, s = 2 * (vcu & 3) + (i >> 1), b = bh >> 4, h = bh & 15;
                {
                    const int k = i & 1; const int qb = k == 0 ? s : 15 - s;
                    att::UnitP P{}; P.tfill = (i == 0);
                    const size_t row0 = (size_t)b * SEQ;
                    P.Qp = QB + row0 * DM + h * 64; P.qrs = DM; P.img = 1; P.Kp = KI + (size_t)(bh * 64) * 4096; P.Vp = VI + (size_t)(bh * 64) * 4096;
                    P.q0 = qb * 256; P.t_lo = 0; P.NT = 4 * (qb + 1);
                    P.cseq = FLOG + (size_t)bh * SEQ;
                    P.Op = O1 + row0 * DM + h * 64; P.ors = DM;
                    return P;
                } };
            att::bf16x8 qrc[4]; { const int z_ = __float_as_int(opaque_zero()); const att::u32x4 z4_ = {(unsigned)z_, (unsigned)z_, (unsigned)z_, (unsigned)z_}; qrc[0] = qrc[1] = qrc[2] = qrc[3] = __builtin_bit_cast(att::bf16x8, z4_); } unsigned long long mkc = ~0ull;
#pragma unroll 1
            for (int i = 0; i < 4; ++i) {
                att::UnitP P = mk(i); P.pre = (i > 0);
                if (i + 1 < 4) { const att::UnitP N = mk(i + 1); P.nQp = N.Qp; P.nKp = N.Kp; P.nVp = N.Vp; P.nq0 = N.q0; P.ntlo = N.t_lo; P.nNT = N.NT; }
                att::attn_unit<att::HK_FOX, 8>(P, (char*)lds, wave_s, qrc, mkc);
            }
            did = true;
        }
        if (st == 5 || st == 7) {
            const bool c = (st == 5);
            pg8::Gemm g{c ? O1 : HB, c ? Wout : Wdn, MTOK, DM, c ? DM : FF, c ? DM : FF, c ? 0 : 1};   pg8::StaticOrder S; S.init(MTOK, DM, G, bx);
            if (c && L == 0) { pg8::EpiRes<true, false> E{x_in, nullptr, XB, rssB}; pg8::gemm_phase<pg8::EpiRes<true, false>, pg8::StaticOrder, true, true>(ldsL, g, S, E, wave_s); }
            else if (!c && L == 3) { pg8::EpiRes<false, true> E{nullptr, xres, XB, nullptr}; pg8::gemm_phase<pg8::EpiRes<false, true>, pg8::StaticOrder, true, true>(ldsL, g, S, E, wave_s); }
            else { pg8::EpiRes<false, false> E{nullptr, nullptr, XB, c ? rssB : rssA}; pg8::gemm_phase<pg8::EpiRes<false, false>, pg8::StaticOrder, true, true>(ldsL, g, S, E, wave_s); }
            did = true;
        }
        if (st == 6) {
            pg8::Gemm g{XB, Wup, MTOK, FF, DM, DM, 1}; pg8::StaticOrder S; S.init(MTOK, FF, G, bx);
            auto pre = [&](int tid) __attribute__((always_inline)) { pg8::rstd_prepass(S, rssB, (LAS float*)(ldsL + LDS_RSTD), tid); };
            pg8::EpiUp E{HB, (const LAS float*)(ldsL + LDS_RSTD)};
            pg8::gemm_phase<pg8::EpiUp, pg8::StaticOrder, true, true>(ldsL, g, S, E, wave_s, pre);
            did = true;
        }
        if (did && !(L == 3 && st == 7)) XBAR();
      }
    }
}

extern "C" void kernel_launch(void* const* d_in, const int* in_sizes, int n_in, void* d_out, int out_size, void* d_ws, size_t ws_size, hipStream_t stream) {
    static int grid = 0;
    if (grid == 0) {
        if (n_in != 17 || out_size != MTOK * DM || ws_size < WS_END) { fprintf(stderr, "kernel_launch: unexpected problem (n_in %d, out %d, ws %zu)\n", n_in, out_size, ws_size); grid = -1; return; }
        int dev = 0, cus = 0, per_cu = 0;
        (void)hipGetDevice(&dev); (void)hipDeviceGetAttribute(&cus, hipDeviceAttributeMultiprocessorCount, dev);
        if (hipFuncSetAttribute((const void*)fwd_mega, hipFuncAttributeMaxDynamicSharedMemorySize, LDS_BYTES) != hipSuccess) { fprintf(stderr, "kernel_launch: hipFuncSetAttribute failed\n"); grid = -1; return; }
        if (hipOccupancyMaxActiveBlocksPerMultiprocessor(&per_cu, (const void*)fwd_mega, 512, LDS_BYTES) != hipSuccess || per_cu < 1) { fprintf(stderr, "kernel_launch: occupancy query says %d\n", per_cu); per_cu = 1; }
        (void)hipGetLastError();
        if (per_cu < 1 || cus * per_cu < 256) { fprintf(stderr, "kernel_launch: needs 256 co-resident workgroups, device offers %d x %d\n", cus, per_cu); grid = -1; return; }
        grid = 256;
    }
    if (grid < 0) return;
    Args a{};
    for (int i = 0; i < 17; ++i) a.in[i] = (const float*)d_in[i];
    a.out = (float*)d_out; a.ws = (unsigned char*)d_ws;
    if (hipMemsetAsync((char*)d_ws + WS_BAR, 0, XCD_BAR_WORDS * 4, stream) != hipSuccess) { fprintf(stderr, "kernel_launch: memset of the barrier words failed\n"); return; }
    void* kargs[] = {&a};
    hipError_t e = hipLaunchCooperativeKernel((const void*)fwd_mega, dim3(grid), dim3(512), kargs, LDS_BYTES, stream);
    if (e != hipSuccess) fprintf(stderr, "cooperative launch failed: %s (grid %d)\n", hipGetErrorString(e), grid);
}
```
